# Optimizing an MI355X kernel written in HIP

```python
import math
import jax, jax.numpy as jnp
from jax import lax
import numpy as np

D_MODEL = 1024
BATCH = 16
SEQ = 2048
DEPTH = 2

D_MIX = D_MODEL
DIFF_HEADS = 4
DIFF_QK_DIM = D_MIX // 16
DIFF_V_DIM = 2 * DIFF_QK_DIM
RET_HEADS = 4
RET_K_DIM = D_MIX // 16
RET_V_DIM = D_MIX // 8
D_FF = ((8 * D_MODEL // 3 + 255) // 256) * 256
Q_BLOCK = 128
RET_CHUNK = 128
NORM_EPS = 1e-6
HALF_STEP = 0.5
LAMBDA_INIT_STD = 0.1

DIFF_QK_W = DIFF_HEADS * 2 * DIFF_QK_DIM
DIFF_V_W = DIFF_HEADS * DIFF_V_DIM
RET_QK_W = RET_HEADS * RET_K_DIM
RET_V_W = RET_HEADS * RET_V_DIM
IN_COLS = 2 * DIFF_QK_W + DIFF_V_W + 2 * RET_QK_W + 2 * RET_V_W
OUT_ROWS = DIFF_V_W + RET_V_W

kernel_name = 'hymba_diffattn_retention_macaron'


def rmsnorm(x, g):
    xf = x.astype(jnp.float32)
    y = xf * lax.rsqrt(jnp.mean(xf * xf, axis=-1, keepdims=True) + NORM_EPS)
    return (y * g.astype(jnp.float32)).astype(x.dtype)


def head_rms(x):
    return x * lax.rsqrt(jnp.mean(x * x, axis=-1, keepdims=True) + NORM_EPS)


def swiglu(x, w_gate, w_up, w_down):
    return (jax.nn.silu(x @ w_gate) * (x @ w_up)) @ w_down


def alibi_slopes(n_heads):
    return jnp.asarray(2.0 ** (-8.0 * np.arange(1, n_heads + 1) / n_heads), dtype=jnp.float32)


def retention_log_decay(n_heads):
    return jnp.asarray(np.log(1.0 - 2.0 ** (-5.0 - np.arange(n_heads))), dtype=jnp.float32)


def diff_heads(t, B, S):
    return jnp.transpose(t.reshape(B, S, DIFF_HEADS, 2, DIFF_QK_DIM), (0, 2, 3, 1, 4))


def diff_attention(q, k, v, lam, lam_init, subln_g):
    B, H, _, S, d = q.shape
    dv = v.shape[-1]
    nb = S // Q_BLOCK
    scale = d ** -0.5
    slopes = alibi_slopes(H)
    key_pos = jnp.arange(S)
    q_blocks = jnp.moveaxis(q.reshape(B, H, 2, nb, Q_BLOCK, d), 3, 0)
    g = subln_g.astype(jnp.float32)

    def block(args):
        idx, qb = args
        q_pos = idx * Q_BLOCK + jnp.arange(Q_BLOCK)
        dist = (q_pos[:, None] - key_pos[None, :]).astype(jnp.float32)
        bias = -slopes[:, None, None] * dist
        s = jnp.einsum('bhcqd,bhckd->bhcqk', qb, k).astype(jnp.float32) * scale + bias[None, :, None]
        s = jnp.where(dist >= 0, s, -jnp.inf)
        p = jax.nn.softmax(s, axis=-1)
        probs = p[:, :, 0] - lam * p[:, :, 1]
        o = jnp.einsum('bhqk,bhkv->bhqv', probs.astype(v.dtype), v).astype(jnp.float32)
        return head_rms(o) * g * (1.0 - lam_init)

    out = lax.map(block, (jnp.arange(nb), q_blocks))
    return jnp.transpose(out, (1, 0, 3, 2, 4)).reshape(B, S, H * dv)


def retention(q, k, v):
    B, S, H, dk = q.shape
    dv = v.shape[-1]
    C = RET_CHUNK
    N = S // C
    lg = retention_log_decay(H)
    q = q.reshape(B, N, C, H, dk)
    k = k.reshape(B, N, C, H, dk) * (dk ** -0.5)
    v = v.reshape(B, N, C, H, dv)
    pos = jnp.arange(C, dtype=jnp.float32)
    rel = pos[:, None] - pos[None, :]
    intra = jnp.where(rel >= 0, jnp.exp(lg[:, None, None] * rel), 0.0)
    scores = jnp.einsum('bnihd,bnjhd->bnhij', q, k) * intra
    inner = jnp.einsum('bnhij,bnjhv->bnihv', scores, v)
    tail = jnp.exp(lg[:, None] * (C - 1.0 - pos))
    kv = jnp.einsum('bnjhd,bnjhv,hj->nbhdv', k, v, tail)
    chunk_decay = jnp.exp(lg * C)[None, :, None, None]

    def step(state, kv_n):
        return state * chunk_decay + kv_n, state

    _, prev = lax.scan(step, jnp.zeros(kv.shape[1:], kv.dtype), kv)
    head = jnp.exp(lg[:, None] * (pos + 1.0))
    cross = jnp.einsum('bnihd,nbhdv,hi->bnihv', q, prev, head)
    o = (inner + cross).astype(jnp.float32)
    return head_rms(o).reshape(B, S, H * dv)


def setup_inputs(seed: int = 0) -> dict:
    key = jax.random.key(seed)
    ks = jax.random.split(key, 20)
    f32 = jnp.float32

    def normal(k, shape, scale):
        return jax.random.normal(k, shape, f32) * scale

    def gain(k, shape):
        return 1.0 + 0.02 * jax.random.normal(k, shape, f32)

    return {
        'x': normal(ks[0], (BATCH, SEQ, D_MODEL), 1.0),
        'norm_ffn1': gain(ks[1], (DEPTH, D_MODEL)),
        'w1_gate': normal(ks[2], (DEPTH, D_MODEL, D_FF), D_MODEL ** -0.5),
        'w1_up': normal(ks[3], (DEPTH, D_MODEL, D_FF), D_MODEL ** -0.5),
        'w1_down': normal(ks[4], (DEPTH, D_FF, D_MODEL), D_FF ** -0.5),
        'norm_mix': gain(ks[5], (DEPTH, D_MODEL)),
        'w_in': normal(ks[6], (DEPTH, D_MODEL, IN_COLS), D_MODEL ** -0.5),
        'lambda_q1': normal(ks[7], (DEPTH, DIFF_QK_DIM), LAMBDA_INIT_STD),
        'lambda_k1': normal(ks[8], (DEPTH, DIFF_QK_DIM), LAMBDA_INIT_STD),
        'lambda_q2': normal(ks[9], (DEPTH, DIFF_QK_DIM), LAMBDA_INIT_STD),
        'lambda_k2': normal(ks[10], (DEPTH, DIFF_QK_DIM), LAMBDA_INIT_STD),
        'diff_subln': gain(ks[11], (DEPTH, DIFF_V_DIM)),
        'w_out': normal(ks[12], (DEPTH, OUT_ROWS, D_MODEL), OUT_ROWS ** -0.5),
        'norm_ffn2': gain(ks[13], (DEPTH, D_MODEL)),
        'w2_gate': normal(ks[14], (DEPTH, D_MODEL, D_FF), D_MODEL ** -0.5),
        'w2_up': normal(ks[15], (DEPTH, D_MODEL, D_FF), D_MODEL ** -0.5),
        'w2_down': normal(ks[16], (DEPTH, D_FF, D_MODEL), D_FF ** -0.5),
        'norm_final': gain(ks[17], (D_MODEL,)),
    }


def reference(x, norm_ffn1, w1_gate, w1_up, w1_down, norm_mix, w_in, lambda_q1, lambda_k1, lambda_q2, lambda_k2, diff_subln, w_out, norm_ffn2, w2_gate, w2_up, w2_down, norm_final):
    B, S, _ = x.shape
    split_at = np.cumsum([DIFF_QK_W, DIFF_QK_W, DIFF_V_W, RET_QK_W, RET_QK_W, RET_V_W]).tolist()
    for l in range(DEPTH):
        x = x + HALF_STEP * swiglu(rmsnorm(x, norm_ffn1[l]), w1_gate[l], w1_up[l], w1_down[l])
        h = rmsnorm(x, norm_mix[l])
        proj = h @ w_in[l]
        dq, dk, dv, rq, rk, rv, rg = jnp.split(proj, split_at, axis=-1)
        lam_init = 0.8 - 0.6 * math.exp(-0.3 * l)
        lam = (jnp.exp(jnp.sum(lambda_q1[l].astype(jnp.float32) * lambda_k1[l].astype(jnp.float32)))
               - jnp.exp(jnp.sum(lambda_q2[l].astype(jnp.float32) * lambda_k2[l].astype(jnp.float32)))
               + lam_init)
        v_heads = jnp.transpose(dv.reshape(B, S, DIFF_HEADS, DIFF_V_DIM), (0, 2, 1, 3))
        o_diff = diff_attention(diff_heads(dq, B, S), diff_heads(dk, B, S), v_heads, lam, lam_init, diff_subln[l])
        o_ret = retention(rq.reshape(B, S, RET_HEADS, RET_K_DIM),
                          rk.reshape(B, S, RET_HEADS, RET_K_DIM),
                          rv.reshape(B, S, RET_HEADS, RET_V_DIM))
        o_ret = jax.nn.silu(rg.astype(jnp.float32)) * o_ret
        mixed = jnp.concatenate([o_diff, o_ret], axis=-1).astype(x.dtype)
        x = x + mixed @ w_out[l]
        x = x + HALF_STEP * swiglu(rmsnorm(x, norm_ffn2[l]), w2_gate[l], w2_up[l], w2_down[l])
    return rmsnorm(x, norm_final)
```

```cpp
#include <hip/hip_runtime.h>
#include <hip/hip_cooperative_groups.h>
#include <cstdio>
#include <cstdint>
namespace cg = cooperative_groups;
namespace pg8 {
#define PG8_LAS __attribute__((address_space(3)))
typedef unsigned short bf16_t;
typedef short bf16x8 __attribute__((ext_vector_type(8)));
typedef float f32x4 __attribute__((ext_vector_type(4)));
typedef unsigned u32x4 __attribute__((ext_vector_type(4)));
constexpr int BM = 256, BK = 64, HALF = 128, HTB = HALF * BK * 2  , STAGE_BYTES = 8 * HTB, NXCD = 8, WGM = 8;

__host__ __device__ __forceinline__ int lds_byte(int r, int c) { const int st = (r >> 4) * 2 + (c >> 5), rr = r & 15, cc = c & 31, ob = rr * 64 + cc * 2; return st * 1024 + (ob ^ (((ob >> 9) & 1) << 5)); }
__host__ __device__ __forceinline__ void stage_rc(int b, int& R, int& C) { const int st = b / 1024, sb = b % 1024, swz = sb ^ (((sb >> 9) & 1) << 5); R = (st >> 1) * 16 + swz / 64; C = (st & 1) * 32 + (swz % 64) / 2; }
__host__ __device__ __forceinline__ int perm32(int rho) { const int n = rho >> 4, i = rho & 15; return 8 * (i >> 2) + 4 * n + (i & 3); }

struct Unit { int pm, pn; };
struct Gemm { const bf16_t* A; const bf16_t* Bt; int M, N, K; };

struct StaticOrder {
    int nM, nN, nwg, G, c;
    __host__ __device__ void init(int M, int N, int G_, int c_) { nM = M / BM; nN = N / BM; nwg = nM * nN; G = G_; c = c_; }
    __host__ __device__ bool next(int i, Unit& u) const {
        const long L = (long)i * G + c; if (L >= nwg) return false;
        int wgid = (int)L; { const int q = nwg / NXCD, r = nwg % NXCD, xcd = wgid % NXCD, off = wgid / NXCD; wgid = (xcd < r ? xcd * (q + 1) : r * (q + 1) + (xcd - r) * q) + off; }
        const int nig = WGM * nN, gid = wgid / nig, fm = gid * WGM, gsz = (nM - fm) < WGM ? (nM - fm) : WGM;
        u.pm = fm + ((wgid % nig) % gsz); u.pn = (wgid % nig) / gsz; return true;
    }
    __device__ __forceinline__ void a_ready(const Unit&) const {}
    __device__ __forceinline__ void done(const Unit&) const {}
};

typedef unsigned u32x2 __attribute__((ext_vector_type(2)));
__device__ __forceinline__ unsigned cvt_pk_bf16(float lo, float hi) { unsigned r; asm volatile("v_cvt_pk_bf16_f32 %0, %1, %2" : "=v"(r) : "v"(lo), "v"(hi)); return r; }
constexpr float RMS_EPS = 1e-6f;
__device__ __forceinline__ float row_rstd(const float* rss, int row, int fq) {
    const f32x4 v = *(const f32x4*)(rss + (size_t)row * 16 + 4 * fq);
    float s = (v[0] + v[1]) + (v[2] + v[3]);
    s += __shfl_xor(s, 16); s += __shfl_xor(s, 32);
    return rsqrtf(s * (1.0f / 1024.0f) + RMS_EPS);
}
__device__ __forceinline__ float silu_mul(float g, float u) {
    const float e = __builtin_amdgcn_exp2f(g * -1.4426950408889634f);
    return g * __builtin_amdgcn_rcpf(1.0f + e) * u;
}
struct EpiSwiglu {
    static constexpr bool PERM = true, AFTER_DRAIN = false;
    bf16_t* H; int ldh; const float* rss;
    __device__ __forceinline__ void operator()(const f32x4 (&acc)[2][2][4][2], const Unit& u, int wr, int wc, int fr, int fq) const {
        const int row0 = u.pm * BM + wr * 64 + fr, col0 = u.pn * HALF + wc * 32 + 8 * fq;
#pragma unroll
        for (int ai = 0; ai < 2; ++ai)
#pragma unroll
            for (int m = 0; m < 4; ++m) {
                const int row = row0 + ai * HALF + m * 16;
                const float r = row_rstd(rss, row, fq);
                const f32x4 g0 = acc[ai][0][m][0] * r, g1 = acc[ai][0][m][1] * r, u0 = acc[ai][1][m][0] * r, u1 = acc[ai][1][m][1] * r;
                u32x4 w;
                w.x = cvt_pk_bf16(silu_mul(g0[0], u0[0]), silu_mul(g0[1], u0[1])); w.y = cvt_pk_bf16(silu_mul(g0[2], u0[2]), silu_mul(g0[3], u0[3]));
                w.z = cvt_pk_bf16(silu_mul(g1[0], u1[0]), silu_mul(g1[1], u1[1])); w.w = cvt_pk_bf16(silu_mul(g1[2], u1[2]), silu_mul(g1[3], u1[3]));
                *(u32x4*)(H + (size_t)row * ldh + col0) = w;
                asm volatile("" ::: "memory");
            }
    }
};
struct EpiProj {
    static constexpr bool PERM = true, AFTER_DRAIN = false;
    bf16_t* O; int ldc; const float* rss;
    __device__ __forceinline__ void operator()(const f32x4 (&acc)[2][2][4][2], const Unit& u, int wr, int wc, int fr, int fq) const {
        const int row0 = u.pm * BM + wr * 64 + fr, col0 = u.pn * BM + wc * 32 + 8 * fq;
#pragma unroll
        for (int ai = 0; ai < 2; ++ai)
#pragma unroll
            for (int m = 0; m < 4; ++m) {
                const int row = row0 + ai * HALF + m * 16;
                const float r = row_rstd(rss, row, fq);
                bf16_t* rowp = O + (size_t)row * ldc + col0;
#pragma unroll
                for (int bj = 0; bj < 2; ++bj) { const f32x4 v0 = acc[ai][bj][m][0] * r, v1 = acc[ai][bj][m][1] * r;
                    u32x4 w; w.x = cvt_pk_bf16(v0[0], v0[1]); w.y = cvt_pk_bf16(v0[2], v0[3]); w.z = cvt_pk_bf16(v1[0], v1[1]); w.w = cvt_pk_bf16(v1[2], v1[3]);
                    *(u32x4*)(rowp + bj * HALF) = w; }
                asm volatile("" ::: "memory");
            }
    }
};
struct EpiResid {
    static constexpr bool PERM = false, AFTER_DRAIN = false;
    const float* res; float* X; bf16_t* XB; float* rss; float alpha;
    __device__ __forceinline__ void operator()(const f32x4 (&acc)[2][2][4][2], const Unit& u, int wr, int wc, int fr, int fq) const {
        const int row0 = u.pm * BM + wr * 64 + fr, col0 = u.pn * BM + wc * 32 + 4 * fq;
#pragma unroll
        for (int ai = 0; ai < 2; ++ai)
#pragma unroll
            for (int m = 0; m < 4; ++m) {
                const int row = row0 + ai * HALF + m * 16; const size_t off = (size_t)row * 1024 + col0; float ss = 0.f;
#pragma unroll
                for (int bj = 0; bj < 2; ++bj) {
                    const f32x4 ra = *(const f32x4*)(res + off + bj * HALF), rb = *(const f32x4*)(res + off + bj * HALF + 16);
                    const f32x4 va = ra + acc[ai][bj][m][0] * alpha, vb = rb + acc[ai][bj][m][1] * alpha;
                    *(f32x4*)(X + off + bj * HALF) = va; *(f32x4*)(X + off + bj * HALF + 16) = vb;
                    ss += (va[0] * va[0] + va[1] * va[1]) + (va[2] * va[2] + va[3] * va[3]) + (vb[0] * vb[0] + vb[1] * vb[1]) + (vb[2] * vb[2] + vb[3] * vb[3]);
                    u32x2 wa, wb; wa.x = cvt_pk_bf16(va[0], va[1]); wa.y = cvt_pk_bf16(va[2], va[3]); wb.x = cvt_pk_bf16(vb[0], vb[1]); wb.y = cvt_pk_bf16(vb[2], vb[3]);
                    *(u32x2*)(XB + off + bj * HALF) = wa; *(u32x2*)(XB + off + bj * HALF + 16) = wb;
                    asm volatile("" ::: "memory");
                }
                ss += __shfl_xor(ss, 16); ss += __shfl_xor(ss, 32);
                if (fq == 0) rss[(size_t)row * 16 + 4 * u.pn + wc] = ss;
                asm volatile("" ::: "memory");
            }
    }
};

template <class Epi, class Sched, bool ALIGN_EPI = false, bool SP2 = false>
__device__ __forceinline__ void gemm_phase(PG8_LAS unsigned char* lds, const Gemm g, const Sched& S, const Epi& E) {
    int tid_ = threadIdx.x; asm volatile("" : "+v"(tid_));
    const int tid = tid_, wid = __builtin_amdgcn_readfirstlane(tid >> 6), lane = tid & 63, wr = wid >> 2, wc = wid & 3, fr = lane & 15, fq = lane >> 4;
    const int K = g.K, nt = K / BK;
    unsigned voffA[2], voffB[2];
#pragma unroll
    for (int i = 0; i < 2; ++i) { int R, C; stage_rc(tid * 16 + i * 8192, R, C); const int Rb = Epi::PERM ? ((R & ~31) + perm32(R & 31)) : R;
        voffA[i] = (unsigned)(R * K + C) * 2u; voffB[i] = (unsigned)(Rb * K + C) * 2u; }
    const size_t kstep = (size_t)(BK * 2);
    const size_t hstep = (size_t)HALF * K * 2;
    const size_t tstep = 2 * hstep;
    const unsigned ldsw = (unsigned)wid * 1024u;
    const int aoff = lds_byte(wr * 64 + fr, fq * 8), boff = lds_byte(wc * 32 + fr, fq * 8);
#define PG8_SA(b, h) (((b) * 2 + (h)) * HTB)
#define PG8_SB(b, h) ((4 + (b) * 2 + (h)) * HTB)
#define PG8_STAGE(bufoff, gbase, voff) do { _Pragma("unroll") for (int _i = 0; _i < 2; ++_i) \
        __builtin_amdgcn_global_load_lds((const unsigned*)((const char*)(gbase) + (voff)[_i]), (PG8_LAS unsigned*)(lds + (bufoff) + ldsw + _i * 8192), 16, 0, 0); } while (0)
#define PG8_LDA(dst, b, h) do { _Pragma("unroll") for (int m = 0; m < 4; ++m) _Pragma("unroll") for (int k = 0; k < 2; ++k) dst[m][k] = *(const PG8_LAS bf16x8*)(lds + PG8_SA(b, h) + aoff + m * 2048 + k * 1024); } while (0)
#define PG8_LDB(dst, b, h) do { _Pragma("unroll") for (int n = 0; n < 2; ++n) _Pragma("unroll") for (int k = 0; k < 2; ++k) dst[n][k] = *(const PG8_LAS bf16x8*)(lds + PG8_SB(b, h) + boff + n * 2048 + k * 1024); } while (0)
#define PG8_MMA(ai, bj, At, Bt) do { __builtin_amdgcn_s_setprio(1); _Pragma("unroll") for (int m = 0; m < 4; ++m) _Pragma("unroll") for (int n = 0; n < 2; ++n) _Pragma("unroll") for (int k = 0; k < 2; ++k) \
        acc[ai][bj][m][n] = __builtin_amdgcn_mfma_f32_16x16x32_bf16(Bt[n][k], At[m][k], acc[ai][bj][m][n], 0, 0, 0); __builtin_amdgcn_s_setprio(0); } while (0)
#define PG8_WAIT_V(n) asm volatile("s_waitcnt vmcnt(" #n ")" ::: "memory")
#define PG8_WAIT_L(n) asm volatile("s_waitcnt lgkmcnt(" #n ")" ::: "memory")
#define PG8_BAR __builtin_amdgcn_s_barrier()
#define PG8_SCHED __builtin_amdgcn_sched_barrier(0)
    Unit cur, nxt; int ui = 0;
    if (!S.next(0, cur)) return;
    f32x4 acc[2][2][4][2];
#pragma unroll
    for (int a = 0; a < 2; ++a)
#pragma unroll
        for (int b = 0; b < 2; ++b)
#pragma unroll
            for (int m = 0; m < 4; ++m)
#pragma unroll
                for (int n = 0; n < 2; ++n) acc[a][b][m][n] = (f32x4){0.f, 0.f, 0.f, 0.f};
    bf16x8 At[4][2], B0[2][2], B1[2][2];
    const char* cA = (const char*)g.A + (size_t)cur.pm * tstep; const char* cB = (const char*)g.Bt + (size_t)cur.pn * tstep;
    S.a_ready(cur);
    if constexpr (SP2) {
        PG8_STAGE(PG8_SB(0, 0), cB, voffB); PG8_STAGE(PG8_SB(0, 1), cB + hstep, voffB); PG8_STAGE(PG8_SA(0, 0), cA, voffA); PG8_STAGE(PG8_SA(0, 1), cA + hstep, voffA);
        if (wr == 1) PG8_BAR;
        PG8_WAIT_V(2); PG8_BAR;
        PG8_STAGE(PG8_SB(1, 0), cB + kstep, voffB); PG8_STAGE(PG8_SA(1, 0), cA + kstep, voffA); PG8_STAGE(PG8_SB(1, 1), cB + hstep + kstep, voffB);
        PG8_WAIT_V(6); PG8_BAR;
    } else {
        PG8_STAGE(PG8_SB(0, 0), cB, voffB); PG8_STAGE(PG8_SA(0, 0), cA, voffA); PG8_STAGE(PG8_SB(0, 1), cB + hstep, voffB); PG8_STAGE(PG8_SA(0, 1), cA + hstep, voffA);
        if (wr == 1) PG8_BAR;
        PG8_WAIT_V(4); PG8_BAR;
        PG8_STAGE(PG8_SB(1, 0), cB + kstep, voffB); PG8_STAGE(PG8_SA(1, 0), cA + kstep, voffA); PG8_STAGE(PG8_SB(1, 1), cB + hstep + kstep, voffB);
        PG8_WAIT_V(6); PG8_BAR;
    }
    for (;;) {
        const bool has_next = S.next(ui + 1, nxt);
        const char* nA = has_next ? (const char*)g.A + (size_t)nxt.pm * tstep : cA; const char* nB = has_next ? (const char*)g.Bt + (size_t)nxt.pn * tstep : cB;
        for (int t = 0; t < nt; t += 2) {
            const bool last = (t == nt - 2);
            const char* a1 = cA + (size_t)(t + 1) * kstep;
            const char* a2 = last ? nA : cA + (size_t)(t + 2) * kstep; const char* b2 = last ? nB : cB + (size_t)(t + 2) * kstep;
            const char* a3 = a2 + kstep; const char* b3 = b2 + kstep;
            if (last && has_next) S.a_ready(nxt);
            if constexpr (SP2) {
            PG8_LDB(B0, 0, 0); PG8_LDB(B1, 0, 1); PG8_SCHED; PG8_LDA(At, 0, 0); PG8_STAGE(PG8_SA(1, 1), a1 + hstep, voffA);
            PG8_WAIT_V(8); PG8_WAIT_L(0); PG8_BAR; PG8_MMA(0, 0, At, B0); PG8_MMA(0, 1, At, B1); PG8_BAR; PG8_SCHED;
            PG8_LDA(At, 0, 1); PG8_STAGE(PG8_SB(0, 0), b2, voffB); PG8_STAGE(PG8_SB(0, 1), b2 + hstep, voffB); PG8_STAGE(PG8_SA(0, 0), a2, voffA);
            PG8_WAIT_V(8); PG8_WAIT_L(0); PG8_BAR; PG8_MMA(1, 0, At, B0); PG8_MMA(1, 1, At, B1); PG8_BAR; PG8_SCHED;
            PG8_LDB(B0, 1, 0); PG8_LDB(B1, 1, 1); PG8_SCHED; PG8_LDA(At, 1, 0); PG8_STAGE(PG8_SA(0, 1), a2 + hstep, voffA);
            PG8_WAIT_V(8); PG8_WAIT_L(0); PG8_BAR; PG8_MMA(0, 0, At, B0); PG8_MMA(0, 1, At, B1); PG8_BAR; PG8_SCHED;
            PG8_LDA(At, 1, 1); PG8_STAGE(PG8_SB(1, 0), b3, voffB); PG8_STAGE(PG8_SB(1, 1), b3 + hstep, voffB); PG8_STAGE(PG8_SA(1, 0), a3, voffA);
            PG8_WAIT_V(8); PG8_WAIT_L(0); PG8_BAR; PG8_MMA(1, 0, At, B0); PG8_MMA(1, 1, At, B1); PG8_BAR; PG8_SCHED;
            } else {
            PG8_LDB(B0, 0, 0); PG8_SCHED; PG8_LDA(At, 0, 0); PG8_STAGE(PG8_SA(1, 1), a1 + hstep, voffA);
            PG8_WAIT_L(8); PG8_BAR; PG8_WAIT_L(0); PG8_MMA(0, 0, At, B0); PG8_BAR; PG8_SCHED;
            PG8_LDB(B1, 0, 1); PG8_STAGE(PG8_SB(0, 0), b2, voffB);
            PG8_BAR; PG8_WAIT_L(0); PG8_MMA(0, 1, At, B1); PG8_BAR;
            PG8_LDA(At, 0, 1); PG8_STAGE(PG8_SA(0, 0), a2, voffA);
            PG8_BAR; PG8_WAIT_L(0); PG8_MMA(1, 0, At, B0); PG8_BAR; PG8_SCHED;
            PG8_STAGE(PG8_SB(0, 1), b2 + hstep, voffB);
            PG8_WAIT_V(6); PG8_BAR; PG8_MMA(1, 1, At, B1); PG8_BAR;
            PG8_LDB(B0, 1, 0); PG8_SCHED; PG8_LDA(At, 1, 0); PG8_STAGE(PG8_SA(0, 1), a2 + hstep, voffA);
            PG8_WAIT_L(8); PG8_BAR; PG8_WAIT_L(0); PG8_MMA(0, 0, At, B0); PG8_BAR; PG8_SCHED;
            PG8_LDB(B1, 1, 1); PG8_STAGE(PG8_SB(1, 0), b3, voffB);
            PG8_BAR; PG8_WAIT_L(0); PG8_MMA(0, 1, At, B1); PG8_BAR;
            PG8_LDA(At, 1, 1); PG8_STAGE(PG8_SA(1, 0), a3, voffA);
            PG8_BAR; PG8_WAIT_L(0); PG8_MMA(1, 0, At, B0); PG8_BAR; PG8_SCHED;
            PG8_STAGE(PG8_SB(1, 1), b3 + hstep, voffB);
            PG8_WAIT_V(6); PG8_BAR; PG8_MMA(1, 1, At, B1); PG8_BAR;
            }
        }
        if constexpr (ALIGN_EPI) { if (wr == 0) PG8_BAR; }
        if constexpr (!Epi::AFTER_DRAIN) { E(acc, cur, wr, wc, fr, fq); S.done(cur); }
        if (!has_next) break;
#pragma unroll
        for (int a = 0; a < 2; ++a)
#pragma unroll
            for (int b = 0; b < 2; ++b)
#pragma unroll
                for (int m = 0; m < 4; ++m)
#pragma unroll
                    for (int n = 0; n < 2; ++n) acc[a][b][m][n] = (f32x4){0.f, 0.f, 0.f, 0.f};
        cur = nxt; cA = nA; cB = nB; ++ui;
        if constexpr (ALIGN_EPI) { if (wr == 1) PG8_BAR; }
    }
    PG8_WAIT_V(0);
    if constexpr (!ALIGN_EPI) { if (wr == 0) PG8_BAR; }
    PG8_BAR;
    if constexpr (Epi::AFTER_DRAIN) { E.fused(acc, cur, wr, wc, fr, fq, lds, wid, lane); S.done(cur); }
#undef PG8_SA
#undef PG8_SB
#undef PG8_STAGE
#undef PG8_LDA
#undef PG8_LDB
#undef PG8_MMA
#undef PG8_WAIT_V
#undef PG8_WAIT_L
#undef PG8_BAR
#undef PG8_SCHED
}
}

namespace att {
#define ATT_LAS __attribute__((address_space(3)))
typedef unsigned short bf16_t;
typedef short bf16x8 __attribute__((ext_vector_type(8)));
typedef short s16x4 __attribute__((ext_vector_type(4)));
typedef float f32x16 __attribute__((ext_vector_type(16)));
typedef float f32x4 __attribute__((ext_vector_type(4)));
typedef unsigned u32x4 __attribute__((ext_vector_type(4)));
typedef unsigned u32x2 __attribute__((ext_vector_type(2)));
constexpr int SEQ = 2048, PP = 3072, MIXP = 1024;
constexpr float LOG2E = 1.4426950408889634f;
#define ATT_MFMA(a, b, c) __builtin_amdgcn_mfma_f32_32x32x16_bf16((a), (b), (c), 0, 0, 0)
__device__ __forceinline__ constexpr int crow0(int i) { return (i & 3) + 8 * (i >> 2); }
__device__ __forceinline__ unsigned cvtpk(float lo, float hi) { typedef float f2 __attribute__((ext_vector_type(2))); typedef __bf16 b2 __attribute__((ext_vector_type(2)));
    f2 v = {lo, hi}; b2 b = __builtin_convertvector(v, b2); return __builtin_bit_cast(unsigned, b); }
__device__ __forceinline__ s16x4 vtr(const ATT_LAS unsigned char* p) { typedef short v4i16_t __attribute__((ext_vector_type(4)));
    return __builtin_bit_cast(s16x4, __builtin_amdgcn_ds_read_tr16_b64_v4i16((ATT_LAS v4i16_t*)p)); }
__device__ __forceinline__ float bf2f(unsigned short b) { return __uint_as_float((unsigned)b << 16); }

template <bool RET>
__device__ __forceinline__ void unit(ATT_LAS unsigned char* lds, const bf16_t* __restrict__ proj, bf16_t* __restrict__ mix, int b, int h, int qb,
                                     float lam, float omli  , const float* __restrict__ subln) {
    constexpr int NMAP = RET ? 1 : 2;
    constexpr int KW = RET ? 64 : 128;
    constexpr int KP = KW * 2 + 16;
    constexpr int KIMG = 64 * KP, VIMG = 16384, BUF = KIMG + VIMG;
    constexpr int QOFF = 2 * BUF;
    constexpr int QCOL = RET ? 1536 : 0, KCOL = RET ? 1792 : 512, VCOL = RET ? 2048 : 1024;
    int tid_ = threadIdx.x; asm volatile("" : "+v"(tid_));
    const int tid = tid_, lane = tid & 63, r = lane & 31, hh = lane >> 5;
    const int wid = __builtin_amdgcn_readfirstlane(tid >> 6);
    const size_t rowbase = (size_t)b * SEQ;
    const int q0w = qb * 256 + wid * 32;
    const int NT = 4 * (qb + 1);
    const int my_last = (q0w + 31) >> 6;
    const float hc0 = RET ? __builtin_log2f(1.0f - __builtin_exp2f(-5.0f - (float)h)) : __builtin_exp2f(-2.0f * (float)(h + 1)) * LOG2E;

    bf16x8 qf[4];
    const int qpark = QOFF + wid * 8192 + lane * 16;
    { const bf16_t* qp = proj + (rowbase + q0w + r) * PP + QCOL + h * KW + 8 * hh;
#pragma unroll
      for (int c = 0; c < NMAP; ++c)
#pragma unroll
          for (int s = 0; s < 4; ++s) { const bf16x8 v = *(const bf16x8*)(qp + c * 64 + 16 * s);
              if constexpr (RET) qf[s] = v; else *(ATT_LAS bf16x8*)(lds + qpark + (c * 4 + s) * 1024) = v; } }

    const char* pbase = (const char*)(proj + rowbase * PP);
    const int vkey = tid >> 4, vc = tid & 15;
    const unsigned voff = (unsigned)(vkey * PP + h * 128 + vc * 8) * 2u;
    const int vdst = KIMG + (vc >> 2) * 4096 + vkey * 64 + (vc & 3) * 16;
    const int kkey = RET ? (tid >> 3) : (tid >> 4), kc = RET ? (tid & 7) : (tid & 15);
    const unsigned koff = (unsigned)(kkey * PP + h * KW + kc * 8) * 2u;
    const int kdst = kkey * KP + kc * 16;
    u32x4 kreg0, kreg1, vreg0, vreg1;
#define ATT_GLOAD(t) do { const char* tb_ = pbase + (size_t)(t) * (64 * PP * 2); \
        kreg0 = *(const u32x4*)(tb_ + KCOL * 2 + koff); if constexpr (!RET) kreg1 = *(const u32x4*)(tb_ + KCOL * 2 + 32 * PP * 2 + koff); \
        vreg0 = *(const u32x4*)(tb_ + VCOL * 2 + voff); vreg1 = *(const u32x4*)(tb_ + VCOL * 2 + 32 * PP * 2 + voff); } while (0)
#define ATT_LWRITE(bo) do { *(ATT_LAS u32x4*)(lds + (bo) + kdst) = kreg0; if constexpr (!RET) *(ATT_LAS u32x4*)(lds + (bo) + kdst + 32 * KP) = kreg1; \
        *(ATT_LAS u32x4*)(lds + (bo) + vdst) = vreg0; *(ATT_LAS u32x4*)(lds + (bo) + vdst + 2048) = vreg1; } while (0)

    f32x16 O[NMAP][4];
#pragma unroll
    for (int c = 0; c < NMAP; ++c)
#pragma unroll
        for (int k = 0; k < 4; ++k)
#pragma unroll
            for (int i = 0; i < 16; ++i) O[c][k][i] = 0.f;
    float mref[NMAP], lsum[NMAP];
#pragma unroll
    for (int c = 0; c < NMAP; ++c) { mref[c] = -1e30f; lsum[c] = 0.f; }

    const int krd = r * KP + 16 * hh;
    const int vrd = KIMG + ((lane >> 4) & 1) * 32 + (lane & 3) * 8 + (4 * hh + ((lane & 15) >> 2)) * 64;

    ATT_GLOAD(0); ATT_LWRITE(0);
    __syncthreads();
    for (int t = 0; t < NT; ++t) {
        const int bo = (t & 1) * BUF;
        if (t + 1 < NT) ATT_GLOAD(t + 1);
        if (t <= my_last) {
            const bool diag = (t == my_last);
            float hc = hc0; asm volatile("" : "+v"(hc));
#pragma unroll
            for (int c = 0; c < NMAP; ++c) {
                if constexpr (!RET) {
#pragma unroll
                    for (int s = 0; s < 4; ++s) qf[s] = *(const ATT_LAS bf16x8*)(lds + qpark + (c * 4 + s) * 1024);
                }
#pragma unroll
                for (int kb = 0; kb < 2; ++kb) {
                    if (kb == 1 && diag && !(q0w & 32)) continue;
                    const int ql = q0w + r - 64 * t - 4 * hh - 32 * kb;
                    f32x16 sa;
#pragma unroll
                    for (int i = 0; i < 16; ++i) sa[i] = 0.f;
#pragma unroll
                    for (int s = 0; s < 4; ++s) { const bf16x8 kf = *(const ATT_LAS bf16x8*)(lds + bo + krd + kb * 32 * KP + c * 128 + s * 32);
                        sa = ATT_MFMA(kf, qf[s], sa); }
                    if constexpr (!RET) {
                        const float lanec = -hc * (float)ql;
#pragma unroll
                        for (int i = 0; i < 16; ++i) sa[i] = __builtin_fmaf(hc, (float)crow0(i), sa[i]);
                        if (diag) {
#pragma unroll
                            for (int i = 0; i < 16; ++i) if (crow0(i) > ql) sa[i] = -1e30f;
                        }
                        float tmax = sa[0];
#pragma unroll
                        for (int i = 1; i < 16; ++i) tmax = fmaxf(tmax, sa[i]);
                        float tm = tmax + lanec; tm = fmaxf(tm, __shfl_xor(tm, 32));
                        if (__any(tm > mref[c] + 8.0f)) {
                            const float mnew = fmaxf(mref[c], tm), alpha = __builtin_amdgcn_exp2f(mref[c] - mnew);
                            lsum[c] *= alpha; mref[c] = mnew;
#pragma unroll
                            for (int k = 0; k < 4; ++k)
#pragma unroll
                                for (int i = 0; i < 16; ++i) O[c][k][i] *= alpha;
                        }
                        const float e = mref[c] - lanec; float ls = 0.f;
#pragma unroll
                        for (int i = 0; i < 16; ++i) { const float p = __builtin_amdgcn_exp2f(sa[i] - e); sa[i] = p; ls += p; }
                        lsum[c] += ls;
                    } else {
                        const float la = hc * (float)ql;
#pragma unroll
                        for (int i = 0; i < 16; ++i) sa[i] = sa[i] * __builtin_amdgcn_exp2f(__builtin_fmaf(-hc, (float)crow0(i), la));
                        if (diag) {
#pragma unroll
                            for (int i = 0; i < 16; ++i) if (crow0(i) > ql) sa[i] = 0.f;
                        }
                    }
                    bf16x8 pf[2];
#pragma unroll
                    for (int s = 0; s < 2; ++s) { u32x4 w;
                        w.x = cvtpk(sa[8 * s + 0], sa[8 * s + 1]); w.y = cvtpk(sa[8 * s + 2], sa[8 * s + 3]);
                        w.z = cvtpk(sa[8 * s + 4], sa[8 * s + 5]); w.w = cvtpk(sa[8 * s + 6], sa[8 * s + 7]);
                        pf[s] = __builtin_bit_cast(bf16x8, w); }
#pragma unroll
                    for (int k = 0; k < 4; ++k)
#pragma unroll
                        for (int s = 0; s < 2; ++s) {
                            const s16x4 lo = vtr(lds + bo + vrd + k * 4096 + (2 * kb + s) * 1024), hi = vtr(lds + bo + vrd + k * 4096 + (2 * kb + s) * 1024 + 512);
                            const bf16x8 vf = __builtin_shufflevector(lo, hi, 0, 1, 2, 3, 4, 5, 6, 7);
                            O[c][k] = ATT_MFMA(vf, pf[s], O[c][k]);
                        }
                }
            }
        }
        if (t + 1 < NT) ATT_LWRITE(((t + 1) & 1) * BUF);
        __syncthreads();
    }
#undef ATT_GLOAD
#undef ATT_LWRITE
    const size_t orow = rowbase + q0w + r;
    if constexpr (!RET) {
        float l1 = lsum[0], l2 = lsum[1];
        l1 += __shfl_xor(l1, 32); l2 += __shfl_xor(l2, 32);
        const float i1 = 1.0f / l1, i2 = lam / l2;
        float ss = 0.f;
#pragma unroll
        for (int k = 0; k < 4; ++k)
#pragma unroll
            for (int i = 0; i < 16; ++i) { const float o = O[0][k][i] * i1 - O[1][k][i] * i2; O[0][k][i] = o; ss += o * o; }
        ss += __shfl_xor(ss, 32);
        const float rn = rsqrtf(ss * (1.0f / 128.0f) + 1e-6f) * omli;
        bf16_t* op = mix + orow * MIXP + h * 128 + 4 * hh;
#pragma unroll
        for (int k = 0; k < 4; ++k)
#pragma unroll
            for (int g = 0; g < 4; ++g) {
                const f32x4 gv = *(const f32x4*)(subln + 32 * k + 8 * g + 4 * hh);
                u32x2 w; w.x = cvtpk(O[0][k][4 * g + 0] * rn * gv[0], O[0][k][4 * g + 1] * rn * gv[1]); w.y = cvtpk(O[0][k][4 * g + 2] * rn * gv[2], O[0][k][4 * g + 3] * rn * gv[3]);
                *(u32x2*)(op + 32 * k + 8 * g) = w;
            }
    } else {
        float ss = 0.f;
#pragma unroll
        for (int k = 0; k < 4; ++k)
#pragma unroll
            for (int i = 0; i < 16; ++i) ss += O[0][k][i] * O[0][k][i];
        ss += __shfl_xor(ss, 32);
        const float rn = rsqrtf(ss * (1.0f / 128.0f) + 1e-6f);
        const bf16_t* gp = proj + orow * PP + 2560 + h * 128 + 4 * hh;
        bf16_t* op = mix + orow * MIXP + 512 + h * 128 + 4 * hh;
#pragma unroll
        for (int k = 0; k < 4; ++k)
#pragma unroll
            for (int g = 0; g < 4; ++g) {
                const u32x2 gw = *(const u32x2*)(gp + 32 * k + 8 * g);
                float gt[4] = {__uint_as_float(gw.x << 16), __uint_as_float(gw.x & 0xffff0000u), __uint_as_float(gw.y << 16), __uint_as_float(gw.y & 0xffff0000u)};
                float ov[4];
#pragma unroll
                for (int j = 0; j < 4; ++j) { const float sg = gt[j] * __builtin_amdgcn_rcpf(1.0f + __builtin_amdgcn_exp2f(-gt[j] * LOG2E)); ov[j] = O[0][k][4 * g + j] * rn * sg; }
                u32x2 w; w.x = cvtpk(ov[0], ov[1]); w.y = cvtpk(ov[2], ov[3]);
                *(u32x2*)(op + 32 * k + 8 * g) = w;
            }
    }
}
}


#ifndef MK_MULTI_LAUNCH
#define MK_MULTI_LAUNCH 0
#endif
#define LAS __attribute__((address_space(3)))
typedef unsigned short bf16;
typedef float f32x4 __attribute__((ext_vector_type(4)));
typedef unsigned v4u __attribute__((ext_vector_type(4)));
typedef unsigned v2u __attribute__((ext_vector_type(2)));

constexpr int BATCH = 16, SEQ = 2048, D = 1024, DEPTH = 2, FF = 2816, INC = 3072;
constexpr int M = BATCH * SEQ;
constexpr int NPH = 2 + 7 * DEPTH;
constexpr size_t MiB = 1u << 20;
constexpr size_t WS_RSS = 0;
constexpr size_t WS_WFF = 2 * MiB, WFF_SZ = (size_t)2 * FF * D * 2;
constexpr size_t WS_WDN = WS_WFF + 4 * WFF_SZ, WDN_SZ = (size_t)D * FF * 2;
constexpr size_t WS_WIN = WS_WDN + 4 * WDN_SZ, WIN_SZ = (size_t)INC * D * 2;
constexpr size_t WS_WOUT = WS_WIN + 2 * WIN_SZ, WOUT_SZ = (size_t)D * D * 2;
constexpr size_t WS_XB = WS_WOUT + 2 * WOUT_SZ;
constexpr size_t WS_MIX = WS_XB + (size_t)M * D * 2;
constexpr size_t WS_HP = WS_MIX + (size_t)M * D * 2;
constexpr size_t WS_END = WS_HP + (size_t)M * INC * 2;
static_assert(WS_END <= 512 * MiB, "d_ws map");
constexpr int LDS_BYTES = 136 * 1024;

struct Args { const float* in[18]; float* out; unsigned char* ws; int ph_lo, ph_hi; };

__device__ __forceinline__ unsigned f2bf(float f) { unsigned u = __builtin_bit_cast(unsigned, f); return (u + 0x7fffu + ((u >> 16) & 1u)) >> 16; }
__device__ __forceinline__ unsigned pk2(float lo, float hi) { return f2bf(lo) | (f2bf(hi) << 16); }
__device__ __forceinline__ float wave_sum(float v) {
#pragma unroll
    for (int o = 1; o < 64; o <<= 1) v += __shfl_xor(v, o);
    return v;
}
__device__ __forceinline__ void tr_item(const float* __restrict__ W, int K, int N, bf16* __restrict__ WT, const float* __restrict__ gain, float cs, int k0, int n0, int drow0, LAS float* scr, int lane) {
#pragma unroll 8
    for (int i = 0; i < 32; ++i) { const int kk = 2 * i + (lane >> 5); const float g = gain ? gain[k0 + kk] * cs : cs;
        scr[kk * 33 + (lane & 31)] = W[(size_t)(k0 + kk) * N + n0 + (lane & 31)] * g; }
    asm volatile("s_waitcnt lgkmcnt(0)" ::: "memory");
    const int c = lane & 7;
#pragma unroll
    for (int j = 0; j < 4; ++j) { const int n = (lane >> 3) + 8 * j; const LAS float* s = scr + (8 * c) * 33 + n;
        v4u o; o.x = pk2(s[0 * 33], s[1 * 33]); o.y = pk2(s[2 * 33], s[3 * 33]); o.z = pk2(s[4 * 33], s[5 * 33]); o.w = pk2(s[6 * 33], s[7 * 33]);
        *(v4u*)(WT + (size_t)(drow0 + n) * K + k0 + 8 * c) = o; }
    asm volatile("s_waitcnt lgkmcnt(0)" ::: "memory");
}

__global__ void __launch_bounds__(512, 2) mega_fwd(Args args) {
    extern __shared__ __attribute__((aligned(16))) unsigned char lds_raw[];
    LAS unsigned char* lds = (LAS unsigned char*)lds_raw;
    cg::grid_group grid = cg::this_grid();
    const int G = gridDim.x, bx = blockIdx.x;
    const int vcu = (G % 8 == 0) ? (bx % 8) * (G / 8) + bx / 8 : bx;
    unsigned char* ws = args.ws;
    float* RSS = (float*)(ws + WS_RSS);
    bf16* XB = (bf16*)(ws + WS_XB); bf16* MIX = (bf16*)(ws + WS_MIX); bf16* HP = (bf16*)(ws + WS_HP);
    float* X = args.out;
    const int lo = args.ph_lo, hi = args.ph_hi;
#define IN(k) (lo <= (k) && (k) < hi)

#pragma unroll 1
    for (int p = lo; p < hi; ++p) {
    const int pk = (p == 0) ? 7 : (p == NPH - 1) ? 8 : (p - 1) % 7;
    const int l = (p - 1) / 7;
    int tid_ = threadIdx.x; asm volatile("" : "+v"(tid_));
    const int tid = tid_, lane = tid & 63, wave = __builtin_amdgcn_readfirstlane(tid >> 6); (void)tid;
    if (pk == 7) {
        LAS float* scr = (LAS float*)(lds + wave * 16384);
        const int gw = vcu * 8 + wave, NGW = G * 8;
        constexpr int PER_LAYER = 6 * 1408 + 1536 + 512, TOTAL = DEPTH * PER_LAYER;
        for (int g = gw; g < TOTAL; g += NGW) {
            const int ll = g / PER_LAYER; int r = g % PER_LAYER;
            if (r < 4 * 1408) {
                const int m = r / 1408, it = r % 1408, f = m >> 1, up = m & 1;
                const float* W = args.in[f == 0 ? (up ? 3 : 2) : (up ? 15 : 14)] + (size_t)ll * D * FF;
                const float* gain = args.in[f == 0 ? 1 : 13] + ll * D;
                bf16* WT = (bf16*)(ws + WS_WFF + (size_t)(ll * 2 + f) * WFF_SZ);
                const int kb = it / 88, nb = it % 88, n0 = nb * 32;
                tr_item(W, D, FF, WT, gain, 1.0f, kb * 64, n0, 256 * (n0 >> 7) + 128 * up + (n0 & 127), scr, lane);
            } else if (r < 6 * 1408) {
                const int m = r / 1408 - 4, it = r % 1408;
                const float* W = args.in[m == 0 ? 4 : 16] + (size_t)ll * FF * D;
                bf16* WT = (bf16*)(ws + WS_WDN + (size_t)(ll * 2 + m) * WDN_SZ);
                const int kb = it / 32, nb = it % 32;
                tr_item(W, FF, D, WT, nullptr, 1.0f, kb * 64, nb * 32, nb * 32, scr, lane);
            } else if (r < 6 * 1408 + 1536) {
                const int it = r - 6 * 1408, kb = it / 96, nb = it % 96, n0 = nb * 32;
                const float cs = (n0 < 512) ? 0.125f * 1.4426950408889634f : ((n0 >= 1792 && n0 < 2048) ? 0.125f : 1.0f);
                tr_item(args.in[6] + (size_t)ll * D * INC, D, INC, (bf16*)(ws + WS_WIN + (size_t)ll * WIN_SZ), args.in[5] + ll * D, cs, kb * 64, n0, n0, scr, lane);
            } else {
                const int it = r - 6 * 1408 - 1536, kb = it / 32, nb = it % 32;
                tr_item(args.in[12] + (size_t)ll * D * D, D, D, (bf16*)(ws + WS_WOUT + (size_t)ll * WOUT_SZ), nullptr, 1.0f, kb * 64, nb * 32, nb * 32, scr, lane);
            }
        }
        const float* x = args.in[0];
        for (int m = gw; m < M; m += NGW) {
            const f32x4* xr = (const f32x4*)(x + (size_t)m * D) + lane; float s = 0.f;
            v2u* o8 = (v2u*)(XB + (size_t)m * D) + lane;
#pragma unroll
            for (int j = 0; j < 4; ++j) { const f32x4 v = xr[64 * j]; s += (v[0] * v[0] + v[1] * v[1]) + (v[2] * v[2] + v[3] * v[3]);
                v2u w; w.x = pk2(v[0], v[1]); w.y = pk2(v[2], v[3]); o8[64 * j] = w; }
            s = wave_sum(s);
            if (lane < 16) RSS[(size_t)m * 16 + lane] = lane == 0 ? s : 0.f;
        }
    } else if (pk == 0 || pk == 5) {
        const int f = pk == 5;
        pg8::Gemm g{XB, (const bf16*)(ws + WS_WFF + (size_t)(l * 2 + f) * WFF_SZ), M, 2 * FF, D}; pg8::StaticOrder S; S.init(M, 2 * FF, G, bx);
        pg8::EpiSwiglu E{HP, FF, RSS};
        pg8::gemm_phase<pg8::EpiSwiglu, pg8::StaticOrder, true, true>(lds, g, S, E);
    } else if (pk == 2) {
        pg8::Gemm g{XB, (const bf16*)(ws + WS_WIN + (size_t)l * WIN_SZ), M, INC, D}; pg8::StaticOrder S; S.init(M, INC, G, bx);
        pg8::EpiProj E{HP, INC, RSS};
        pg8::gemm_phase<pg8::EpiProj, pg8::StaticOrder, true, true>(lds, g, S, E);
    } else if (pk == 3) {
        const float lam_init = 0.8f - 0.6f * expf(-0.3f * (float)l);
        float s1 = args.in[7][l * 64 + lane] * args.in[8][l * 64 + lane], s2 = args.in[9][l * 64 + lane] * args.in[10][l * 64 + lane];
        s1 = wave_sum(s1); s2 = wave_sum(s2);
        const float lam = expf(s1) - expf(s2) + lam_init;
        const float* subln = args.in[11] + l * 128;
        for (int v = vcu; v < 256; v += G) {
            const int bh = v >> 2, s = v & 3, b = bh >> 2, h = bh & 3;
#pragma unroll 1
            for (int i = 0; i < 2; ++i) att::unit<false>(lds, HP, MIX, b, h, i == 0 ? 7 - s : s, lam, 1.0f - lam_init, subln);
#pragma unroll 1
            for (int i = 0; i < 2; ++i) att::unit<true>(lds, HP, MIX, b, h, i == 0 ? 7 - s : s, 0.f, 0.f, nullptr);
        }
    } else if (pk == 8) {
        const int gw = vcu * 8 + wave, NGW = G * 8;
        const float* gf = args.in[17];
        for (int m = gw; m < M; m += NGW) {
            float s = lane < 16 ? RSS[(size_t)m * 16 + lane] : 0.f; s = wave_sum(s);
            const float rstd = rsqrtf(s * (1.0f / D) + 1e-6f);
            f32x4* xr = (f32x4*)(X + (size_t)m * D) + lane;
#pragma unroll
            for (int j = 0; j < 4; ++j) { const f32x4 gv = ((const f32x4*)gf)[lane + 64 * j]; xr[64 * j] = xr[64 * j] * rstd * gv; }
        }
    } else {
        const bool outp = pk == 4; const int f = pk == 6;
        const bf16* A = outp ? MIX : HP;
        const bf16* Bt = outp ? (const bf16*)(ws + WS_WOUT + (size_t)l * WOUT_SZ) : (const bf16*)(ws + WS_WDN + (size_t)(l * 2 + f) * WDN_SZ);
        pg8::Gemm g{A, Bt, M, D, outp ? D : FF}; pg8::StaticOrder S; S.init(M, D, G, bx);
        pg8::EpiResid E{p == 2 ? args.in[0] : X, X, XB, RSS, outp ? 1.0f : 0.5f};
        pg8::gemm_phase<pg8::EpiResid, pg8::StaticOrder, true, true>(lds, g, S, E);
    }
    if (p + 1 < hi) grid.sync();
    }
#undef IN
}

extern "C" void kernel_launch(void* const* d_in, const int* in_sizes, int n_in, void* d_out, int out_size, void* d_ws, size_t ws_size, hipStream_t stream) {
    static int grid = 0;
    if (grid == 0) {
        if (n_in != 18 || out_size != M * D || ws_size < WS_END) { fprintf(stderr, "kernel_launch: unexpected shapes (n_in %d out %d ws %zu)\n", n_in, out_size, ws_size); grid = -1; return; }
        int dev = 0, cus = 0, per_cu = 0;
        (void)hipGetDevice(&dev); (void)hipDeviceGetAttribute(&cus, hipDeviceAttributeMultiprocessorCount, dev);
        if (hipFuncSetAttribute((const void*)mega_fwd, hipFuncAttributeMaxDynamicSharedMemorySize, LDS_BYTES) != hipSuccess) { fprintf(stderr, "kernel_launch: hipFuncSetAttribute failed\n"); grid = -1; return; }
        if (hipOccupancyMaxActiveBlocksPerMultiprocessor(&per_cu, (const void*)mega_fwd, 512, LDS_BYTES) != hipSuccess || per_cu < 1) { fprintf(stderr, "kernel_launch: occupancy query says %d\n", per_cu); per_cu = 1; }
        (void)hipGetLastError();
        grid = cus * 1;
        if (grid <= 0) grid = 256;
    }
    if (grid < 0) return;
    Args a{};
    for (int i = 0; i < 18; ++i) a.in[i] = (const float*)d_in[i];
    a.out = (float*)d_out; a.ws = (unsigned char*)d_ws;
#if MK_MULTI_LAUNCH
    for (int p = 0; p < NPH; ++p) { a.ph_lo = p; a.ph_hi = p + 1; hipLaunchKernelGGL(mega_fwd, dim3(grid), dim3(512), LDS_BYTES, stream, a); }
#else
    a.ph_lo = 0; a.ph_hi = NPH;
    void* kargs[] = {&a};
    hipError_t e = hipLaunchCooperativeKernel((const void*)mega_fwd, dim3(grid), dim3(512), kargs, LDS_BYTES, stream);
    if (e != hipSuccess) fprintf(stderr, "cooperative launch failed: %s (grid %d)\n", hipGetErrorString(e), grid);
#endif
}
```

```cpp
#include <hip/hip_runtime.h>
#include <hip/hip_cooperative_groups.h>
#include <cstdio>
#include <cstdint>
namespace cg = cooperative_groups;
namespace pg8 {
#define PG8_LAS __attribute__((address_space(3)))
typedef unsigned short bf16_t;
typedef short bf16x8 __attribute__((ext_vector_type(8)));
typedef float f32x4 __attribute__((ext_vector_type(4)));
typedef unsigned u32x4 __attribute__((ext_vector_type(4)));
constexpr int BM = 256, BK = 64, HALF = 128, HTB = HALF * BK * 2  , STAGE_BYTES = 8 * HTB, NXCD = 8, WGM = 8;

__host__ __device__ __forceinline__ int lds_byte(int r, int c) { const int st = (r >> 4) * 2 + (c >> 5), rr = r & 15, cc = c & 31, ob = rr * 64 + cc * 2; return st * 1024 + (ob ^ (((ob >> 9) & 1) << 5)); }
__host__ __device__ __forceinline__ void stage_rc(int b, int& R, int& C) { const int st = b / 1024, sb = b % 1024, swz = sb ^ (((sb >> 9) & 1) << 5); R = (st >> 1) * 16 + swz / 64; C = (st & 1) * 32 + (swz % 64) / 2; }
__host__ __device__ __forceinline__ int perm32(int rho) { const int n = rho >> 4, i = rho & 15; return 8 * (i >> 2) + 4 * n + (i & 3); }

struct Unit { int pm, pn; };
struct Gemm { const bf16_t* A; const bf16_t* Bt; int M, N, K; };

struct StaticOrder {
    int nM, nN, nwg, G, c;
    __host__ __device__ void init(int M, int N, int G_, int c_) { nM = M / BM; nN = N / BM; nwg = nM * nN; G = G_; c = c_; }
    __host__ __device__ bool next(int i, Unit& u) const {
        const long L = (long)i * G + c; if (L >= nwg) return false;
        int wgid = (int)L; { const int q = nwg / NXCD, r = nwg % NXCD, xcd = wgid % NXCD, off = wgid / NXCD; wgid = (xcd < r ? xcd * (q + 1) : r * (q + 1) + (xcd - r) * q) + off; }
        const int nig = WGM * nN, gid = wgid / nig, fm = gid * WGM, gsz = (nM - fm) < WGM ? (nM - fm) : WGM;
        u.pm = fm + ((wgid % nig) % gsz); u.pn = (wgid % nig) / gsz; return true;
    }
    __device__ __forceinline__ void a_ready(const Unit&) const {}
    __device__ __forceinline__ void done(const Unit&) const {}
};

typedef unsigned u32x2 __attribute__((ext_vector_type(2)));
__device__ __forceinline__ unsigned cvt_pk_bf16(float lo, float hi) { unsigned r; asm volatile("v_cvt_pk_bf16_f32 %0, %1, %2" : "=v"(r) : "v"(lo), "v"(hi)); return r; }
constexpr float RMS_EPS = 1e-6f;
__device__ __forceinline__ float row_rstd(const float* rss, int row, int fq) {
    const f32x4 v = *(const f32x4*)(rss + (size_t)row * 16 + 4 * fq);
    float s = (v[0] + v[1]) + (v[2] + v[3]);
    s += __shfl_xor(s, 16); s += __shfl_xor(s, 32);
    return rsqrtf(s * (1.0f / 1024.0f) + RMS_EPS);
}
__device__ __forceinline__ float silu_mul(float g, float u) {
    const float e = __builtin_amdgcn_exp2f(g * -1.4426950408889634f);
    return g * __builtin_amdgcn_rcpf(1.0f + e) * u;
}
struct EpiSwiglu {
    static constexpr bool PERM = true, AFTER_DRAIN = false;
    bf16_t* H; int ldh; const float* rss;
    __device__ __forceinline__ void operator()(const f32x4 (&acc)[2][2][4][2], const Unit& u, int wr, int wc, int fr, int fq) const {
        const int row0 = u.pm * BM + wr * 64 + fr, col0 = u.pn * HALF + wc * 32 + 8 * fq;
#pragma unroll
        for (int ai = 0; ai < 2; ++ai)
#pragma unroll
            for (int m = 0; m < 4; ++m) {
                const int row = row0 + ai * HALF + m * 16;
                const float r = row_rstd(rss, row, fq);
                const f32x4 g0 = acc[ai][0][m][0] * r, g1 = acc[ai][0][m][1] * r, u0 = acc[ai][1][m][0] * r, u1 = acc[ai][1][m][1] * r;
                u32x4 w;
                w.x = cvt_pk_bf16(silu_mul(g0[0], u0[0]), silu_mul(g0[1], u0[1])); w.y = cvt_pk_bf16(silu_mul(g0[2], u0[2]), silu_mul(g0[3], u0[3]));
                w.z = cvt_pk_bf16(silu_mul(g1[0], u1[0]), silu_mul(g1[1], u1[1])); w.w = cvt_pk_bf16(silu_mul(g1[2], u1[2]), silu_mul(g1[3], u1[3]));
                *(u32x4*)(H + (size_t)row * ldh + col0) = w;
                asm volatile("" ::: "memory");
            }
    }
};
struct EpiProj {
    static constexpr bool PERM = true, AFTER_DRAIN = false;
    bf16_t* O; int ldc; const float* rss;
    __device__ __forceinline__ void operator()(const f32x4 (&acc)[2][2][4][2], const Unit& u, int wr, int wc, int fr, int fq) const {
        const int row0 = u.pm * BM + wr * 64 + fr, col0 = u.pn * BM + wc * 32 + 8 * fq;
#pragma unroll
        for (int ai = 0; ai < 2; ++ai)
#pragma unroll
            for (int m = 0; m < 4; ++m) {
                const int row = row0 + ai * HALF + m * 16;
                const float r = row_rstd(rss, row, fq);
                bf16_t* rowp = O + (size_t)row * ldc + col0;
#pragma unroll
                for (int bj = 0; bj < 2; ++bj) { const f32x4 v0 = acc[ai][bj][m][0] * r, v1 = acc[ai][bj][m][1] * r;
                    u32x4 w; w.x = cvt_pk_bf16(v0[0], v0[1]); w.y = cvt_pk_bf16(v0[2], v0[3]); w.z = cvt_pk_bf16(v1[0], v1[1]); w.w = cvt_pk_bf16(v1[2], v1[3]);
                    *(u32x4*)(rowp + bj * HALF) = w; }
                asm volatile("" ::: "memory");
            }
    }
};
struct EpiResid {
    static constexpr bool PERM = false, AFTER_DRAIN = false;
    const float* res; float* X; bf16_t* XB; float* rss; float alpha;
    __device__ __forceinline__ void operator()(const f32x4 (&acc)[2][2][4][2], const Unit& u, int wr, int wc, int fr, int fq) const {
        const int row0 = u.pm * BM + wr * 64 + fr, col0 = u.pn * BM + wc * 32 + 4 * fq;
#pragma unroll
        for (int ai = 0; ai < 2; ++ai)
#pragma unroll
            for (int m = 0; m < 4; ++m) {
                const int row = row0 + ai * HALF + m * 16; const size_t off = (size_t)row * 1024 + col0; float ss = 0.f;
#pragma unroll
                for (int bj = 0; bj < 2; ++bj) {
                    const f32x4 ra = *(const f32x4*)(res + off + bj * HALF), rb = *(const f32x4*)(res + off + bj * HALF + 16);
                    const f32x4 va = ra + acc[ai][bj][m][0] * alpha, vb = rb + acc[ai][bj][m][1] * alpha;
                    *(f32x4*)(X + off + bj * HALF) = va; *(f32x4*)(X + off + bj * HALF + 16) = vb;
                    ss += (va[0] * va[0] + va[1] * va[1]) + (va[2] * va[2] + va[3] * va[3]) + (vb[0] * vb[0] + vb[1] * vb[1]) + (vb[2] * vb[2] + vb[3] * vb[3]);
                    u32x2 wa, wb; wa.x = cvt_pk_bf16(va[0], va[1]); wa.y = cvt_pk_bf16(va[2], va[3]); wb.x = cvt_pk_bf16(vb[0], vb[1]); wb.y = cvt_pk_bf16(vb[2], vb[3]);
                    *(u32x2*)(XB + off + bj * HALF) = wa; *(u32x2*)(XB + off + bj * HALF + 16) = wb;
                    asm volatile("" ::: "memory");
                }
                ss += __shfl_xor(ss, 16); ss += __shfl_xor(ss, 32);
                if (fq == 0) rss[(size_t)row * 16 + 4 * u.pn + wc] = ss;
                asm volatile("" ::: "memory");
            }
    }
};

template <class Epi, class Sched, bool ALIGN_EPI = false, bool SP2 = false>
__device__ __forceinline__ void gemm_phase(PG8_LAS unsigned char* lds, const Gemm g, const Sched& S, const Epi& E) {
    int tid_ = threadIdx.x; asm volatile("" : "+v"(tid_));
    const int tid = tid_, wid = __builtin_amdgcn_readfirstlane(tid >> 6), lane = tid & 63, wr = wid >> 2, wc = wid & 3, fr = lane & 15, fq = lane >> 4;
    const int K = g.K, nt = K / BK;
    unsigned voffA[2], voffB[2];
#pragma unroll
    for (int i = 0; i < 2; ++i) { int R, C; stage_rc(tid * 16 + i * 8192, R, C); const int Rb = Epi::PERM ? ((R & ~31) + perm32(R & 31)) : R;
        voffA[i] = (unsigned)(R * K + C) * 2u; voffB[i] = (unsigned)(Rb * K + C) * 2u; }
    const size_t kstep = (size_t)(BK * 2);
    const size_t hstep = (size_t)HALF * K * 2;
    const size_t tstep = 2 * hstep;
    const unsigned ldsw = (unsigned)wid * 1024u;
    const int aoff = lds_byte(wr * 64 + fr, fq * 8), boff = lds_byte(wc * 32 + fr, fq * 8);
#define PG8_SA(b, h) (((b) * 2 + (h)) * HTB)
#define PG8_SB(b, h) ((4 + (b) * 2 + (h)) * HTB)
#define PG8_STAGE(bufoff, gbase, voff) do { _Pragma("unroll") for (int _i = 0; _i < 2; ++_i) \
        __builtin_amdgcn_global_load_lds((const unsigned*)((const char*)(gbase) + (voff)[_i]), (PG8_LAS unsigned*)(lds + (bufoff) + ldsw + _i * 8192), 16, 0, 0); } while (0)
#define PG8_LDA(dst, b, h) do { _Pragma("unroll") for (int m = 0; m < 4; ++m) _Pragma("unroll") for (int k = 0; k < 2; ++k) dst[m][k] = *(const PG8_LAS bf16x8*)(lds + PG8_SA(b, h) + aoff + m * 2048 + k * 1024); } while (0)
#define PG8_LDB(dst, b, h) do { _Pragma("unroll") for (int n = 0; n < 2; ++n) _Pragma("unroll") for (int k = 0; k < 2; ++k) dst[n][k] = *(const PG8_LAS bf16x8*)(lds + PG8_SB(b, h) + boff + n * 2048 + k * 1024); } while (0)
#define PG8_MMA(ai, bj, At, Bt) do { __builtin_amdgcn_s_setprio(1); _Pragma("unroll") for (int m = 0; m < 4; ++m) _Pragma("unroll") for (int n = 0; n < 2; ++n) _Pragma("unroll") for (int k = 0; k < 2; ++k) \
        acc[ai][bj][m][n] = __builtin_amdgcn_mfma_f32_16x16x32_bf16(Bt[n][k], At[m][k], acc[ai][bj][m][n], 0, 0, 0); __builtin_amdgcn_s_setprio(0); } while (0)
#define PG8_WAIT_V(n) asm volatile("s_waitcnt vmcnt(" #n ")" ::: "memory")
#define PG8_WAIT_L(n) asm volatile("s_waitcnt lgkmcnt(" #n ")" ::: "memory")
#define PG8_BAR __builtin_amdgcn_s_barrier()
#define PG8_SCHED __builtin_amdgcn_sched_barrier(0)
    Unit cur, nxt; int ui = 0;
    if (!S.next(0, cur)) return;
    f32x4 acc[2][2][4][2];
#pragma unroll
    for (int a = 0; a < 2; ++a)
#pragma unroll
        for (int b = 0; b < 2; ++b)
#pragma unroll
            for (int m = 0; m < 4; ++m)
#pragma unroll
                for (int n = 0; n < 2; ++n) acc[a][b][m][n] = (f32x4){0.f, 0.f, 0.f, 0.f};
    bf16x8 At[4][2], B0[2][2], B1[2][2];
    const char* cA = (const char*)g.A + (size_t)cur.pm * tstep; const char* cB = (const char*)g.Bt + (size_t)cur.pn * tstep;
    S.a_ready(cur);
    if constexpr (SP2) {
        PG8_STAGE(PG8_SB(0, 0), cB, voffB); PG8_STAGE(PG8_SB(0, 1), cB + hstep, voffB); PG8_STAGE(PG8_SA(0, 0), cA, voffA); PG8_STAGE(PG8_SA(0, 1), cA + hstep, voffA);
        if (wr == 1) PG8_BAR;
        PG8_WAIT_V(2); PG8_BAR;
        PG8_STAGE(PG8_SB(1, 0), cB + kstep, voffB); PG8_STAGE(PG8_SA(1, 0), cA + kstep, voffA); PG8_STAGE(PG8_SB(1, 1), cB + hstep + kstep, voffB);
        PG8_WAIT_V(6); PG8_BAR;
    } else {
        PG8_STAGE(PG8_SB(0, 0), cB, voffB); PG8_STAGE(PG8_SA(0, 0), cA, voffA); PG8_STAGE(PG8_SB(0, 1), cB + hstep, voffB); PG8_STAGE(PG8_SA(0, 1), cA + hstep, voffA);
        if (wr == 1) PG8_BAR;
        PG8_WAIT_V(4); PG8_BAR;
        PG8_STAGE(PG8_SB(1, 0), cB + kstep, voffB); PG8_STAGE(PG8_SA(1, 0), cA + kstep, voffA); PG8_STAGE(PG8_SB(1, 1), cB + hstep + kstep, voffB);
        PG8_WAIT_V(6); PG8_BAR;
    }
    for (;;) {
        const bool has_next = S.next(ui + 1, nxt);
        const char* nA = has_next ? (const char*)g.A + (size_t)nxt.pm * tstep : cA; const char* nB = has_next ? (const char*)g.Bt + (size_t)nxt.pn * tstep : cB;
        for (int t = 0; t < nt; t += 2) {
            const bool last = (t == nt - 2);
            const char* a1 = cA + (size_t)(t + 1) * kstep;
            const char* a2 = last ? nA : cA + (size_t)(t + 2) * kstep; const char* b2 = last ? nB : cB + (size_t)(t + 2) * kstep;
            const char* a3 = a2 + kstep; const char* b3 = b2 + kstep;
            if (last && has_next) S.a_ready(nxt);
            if constexpr (SP2) {
            PG8_LDB(B0, 0, 0); PG8_LDB(B1, 0, 1); PG8_SCHED; PG8_LDA(At, 0, 0); PG8_STAGE(PG8_SA(1, 1), a1 + hstep, voffA);
            PG8_WAIT_V(8); PG8_WAIT_L(0); PG8_BAR; PG8_MMA(0, 0, At, B0); PG8_MMA(0, 1, At, B1); PG8_BAR; PG8_SCHED;
            PG8_LDA(At, 0, 1); PG8_STAGE(PG8_SB(0, 0), b2, voffB); PG8_STAGE(PG8_SB(0, 1), b2 + hstep, voffB); PG8_STAGE(PG8_SA(0, 0), a2, voffA);
            PG8_WAIT_V(8); PG8_WAIT_L(0); PG8_BAR; PG8_MMA(1, 0, At, B0); PG8_MMA(1, 1, At, B1); PG8_BAR; PG8_SCHED;
            PG8_LDB(B0, 1, 0); PG8_LDB(B1, 1, 1); PG8_SCHED; PG8_LDA(At, 1, 0); PG8_STAGE(PG8_SA(0, 1), a2 + hstep, voffA);
            PG8_WAIT_V(8); PG8_WAIT_L(0); PG8_BAR; PG8_MMA(0, 0, At, B0); PG8_MMA(0, 1, At, B1); PG8_BAR; PG8_SCHED;
            PG8_LDA(At, 1, 1); PG8_STAGE(PG8_SB(1, 0), b3, voffB); PG8_STAGE(PG8_SB(1, 1), b3 + hstep, voffB); PG8_STAGE(PG8_SA(1, 0), a3, voffA);
            PG8_WAIT_V(8); PG8_WAIT_L(0); PG8_BAR; PG8_MMA(1, 0, At, B0); PG8_MMA(1, 1, At, B1); PG8_BAR; PG8_SCHED;
            } else {
            PG8_LDB(B0, 0, 0); PG8_SCHED; PG8_LDA(At, 0, 0); PG8_STAGE(PG8_SA(1, 1), a1 + hstep, voffA);
            PG8_WAIT_L(8); PG8_BAR; PG8_WAIT_L(0); PG8_MMA(0, 0, At, B0); PG8_BAR; PG8_SCHED;
            PG8_LDB(B1, 0, 1); PG8_STAGE(PG8_SB(0, 0), b2, voffB);
            PG8_BAR; PG8_WAIT_L(0); PG8_MMA(0, 1, At, B1); PG8_BAR;
            PG8_LDA(At, 0, 1); PG8_STAGE(PG8_SA(0, 0), a2, voffA);
            PG8_BAR; PG8_WAIT_L(0); PG8_MMA(1, 0, At, B0); PG8_BAR; PG8_SCHED;
            PG8_STAGE(PG8_SB(0, 1), b2 + hstep, voffB);
            PG8_WAIT_V(6); PG8_BAR; PG8_MMA(1, 1, At, B1); PG8_BAR;
            PG8_LDB(B0, 1, 0); PG8_SCHED; PG8_LDA(At, 1, 0); PG8_STAGE(PG8_SA(0, 1), a2 + hstep, voffA);
            PG8_WAIT_L(8); PG8_BAR; PG8_WAIT_L(0); PG8_MMA(0, 0, At, B0); PG8_BAR; PG8_SCHED;
            PG8_LDB(B1, 1, 1); PG8_STAGE(PG8_SB(1, 0), b3, voffB);
            PG8_BAR; PG8_WAIT_L(0); PG8_MMA(0, 1, At, B1); PG8_BAR;
            PG8_LDA(At, 1, 1); PG8_STAGE(PG8_SA(1, 0), a3, voffA);
            PG8_BAR; PG8_WAIT_L(0); PG8_MMA(1, 0, At, B0); PG8_BAR; PG8_SCHED;
            PG8_STAGE(PG8_SB(1, 1), b3 + hstep, voffB);
            PG8_WAIT_V(6); PG8_BAR; PG8_MMA(1, 1, At, B1); PG8_BAR;
            }
        }
        if constexpr (ALIGN_EPI) { if (wr == 0) PG8_BAR; }
        if constexpr (!Epi::AFTER_DRAIN) { E(acc, cur, wr, wc, fr, fq); S.done(cur); }
        if (!has_next) break;
#pragma unroll
        for (int a = 0; a < 2; ++a)
#pragma unroll
            for (int b = 0; b < 2; ++b)
#pragma unroll
                for (int m = 0; m < 4; ++m)
#pragma unroll
                    for (int n = 0; n < 2; ++n) acc[a][b][m][n] = (f32x4){0.f, 0.f, 0.f, 0.f};
        cur = nxt; cA = nA; cB = nB; ++ui;
        if constexpr (ALIGN_EPI) { if (wr == 1) PG8_BAR; }
    }
    PG8_WAIT_V(0);
    if constexpr (!ALIGN_EPI) { if (wr == 0) PG8_BAR; }
    PG8_BAR;
    if constexpr (Epi::AFTER_DRAIN) { E.fused(acc, cur, wr, wc, fr, fq, lds, wid, lane); S.done(cur); }
#undef PG8_SA
#undef PG8_SB
#undef PG8_STAGE
#undef PG8_LDA
#undef PG8_LDB
#undef PG8_MMA
#undef PG8_WAIT_V
#undef PG8_WAIT_L
#undef PG8_BAR
#undef PG8_SCHED
}
}

namespace att {
#define ATT_LAS __attribute__((address_space(3)))
typedef unsigned short bf16_t;
typedef short bf16x8 __attribute__((ext_vector_type(8)));
typedef short s16x4 __attribute__((ext_vector_type(4)));
typedef float f32x16 __attribute__((ext_vector_type(16)));
typedef float f32x4 __attribute__((ext_vector_type(4)));
typedef unsigned u32x4 __attribute__((ext_vector_type(4)));
typedef unsigned u32x2 __attribute__((ext_vector_type(2)));
constexpr int SEQ = 2048, PP = 3072, MIXP = 1024;
constexpr float LOG2E = 1.4426950408889634f;
#define ATT_MFMA(a, b, c) __builtin_amdgcn_mfma_f32_32x32x16_bf16((a), (b), (c), 0, 0, 0)
__device__ __forceinline__ constexpr int crow0(int i) { return (i & 3) + 8 * (i >> 2); }
__device__ __forceinline__ unsigned cvtpk(float lo, float hi) { typedef float f2 __attribute__((ext_vector_type(2))); typedef __bf16 b2 __attribute__((ext_vector_type(2)));
    f2 v = {lo, hi}; b2 b = __builtin_convertvector(v, b2); return __builtin_bit_cast(unsigned, b); }
__device__ __forceinline__ s16x4 vtr(const ATT_LAS unsigned char* p) { typedef short v4i16_t __attribute__((ext_vector_type(4)));
    return __builtin_bit_cast(s16x4, __builtin_amdgcn_ds_read_tr16_b64_v4i16((ATT_LAS v4i16_t*)p)); }
__device__ __forceinline__ float bf2f(unsigned short b) { return __uint_as_float((unsigned)b << 16); }

template <bool RET>
__device__ __forceinline__ void unit(ATT_LAS unsigned char* lds, const bf16_t* __restrict__ proj, bf16_t* __restrict__ mix, int b, int h, int qb,
                                     float lam, float omli  , const float* __restrict__ subln) {
    constexpr int NMAP = RET ? 1 : 2;
    constexpr int KW = RET ? 64 : 128;
    constexpr int KP = KW * 2 + 16;
    constexpr int KIMG = 64 * KP, VIMG = 16384, BUF = KIMG + VIMG;
    constexpr int QOFF = 2 * BUF;
    constexpr int QCOL = RET ? 1536 : 0, KCOL = RET ? 1792 : 512, VCOL = RET ? 2048 : 1024;
    int tid_ = threadIdx.x; asm volatile("" : "+v"(tid_));
    const int tid = tid_, lane = tid & 63, r = lane & 31, hh = lane >> 5;
    const int wid = __builtin_amdgcn_readfirstlane(tid >> 6);
    const size_t rowbase = (size_t)b * SEQ;
    const int q0w = qb * 256 + wid * 32;
    const int NT = 4 * (qb + 1);
    const int my_last = (q0w + 31) >> 6;
    const float hc0 = RET ? __builtin_log2f(1.0f - __builtin_exp2f(-5.0f - (float)h)) : __builtin_exp2f(-2.0f * (float)(h + 1)) * LOG2E;

    bf16x8 qf[4];
    const int qpark = QOFF + wid * 8192 + lane * 16;
    { const bf16_t* qp = proj + (rowbase + q0w + r) * PP + QCOL + h * KW + 8 * hh;
#pragma unroll
      for (int c = 0; c < NMAP; ++c)
#pragma unroll
          for (int s = 0; s < 4; ++s) { const bf16x8 v = *(const bf16x8*)(qp + c * 64 + 16 * s);
              if constexpr (RET) qf[s] = v; else *(ATT_LAS bf16x8*)(lds + qpark + (c * 4 + s) * 1024) = v; } }

    const char* pbase = (const char*)(proj + rowbase * PP);
    const int vkey = tid >> 4, vc = tid & 15;
    const unsigned voff = (unsigned)(vkey * PP + h * 128 + vc * 8) * 2u;
    const int vdst = KIMG + (vc >> 2) * 4096 + vkey * 64 + (vc & 3) * 16;
    const int kkey = RET ? (tid >> 3) : (tid >> 4), kc = RET ? (tid & 7) : (tid & 15);
    const unsigned koff = (unsigned)(kkey * PP + h * KW + kc * 8) * 2u;
    const int kdst = kkey * KP + kc * 16;
    u32x4 kreg0, kreg1, vreg0, vreg1;
#define ATT_GLOAD(t) do { const char* tb_ = pbase + (size_t)(t) * (64 * PP * 2); \
        kreg0 = *(const u32x4*)(tb_ + KCOL * 2 + koff); if constexpr (!RET) kreg1 = *(const u32x4*)(tb_ + KCOL * 2 + 32 * PP * 2 + koff); \
        vreg0 = *(const u32x4*)(tb_ + VCOL * 2 + voff); vreg1 = *(const u32x4*)(tb_ + VCOL * 2 + 32 * PP * 2 + voff); } while (0)
#define ATT_LWRITE(bo) do { *(ATT_LAS u32x4*)(lds + (bo) + kdst) = kreg0; if constexpr (!RET) *(ATT_LAS u32x4*)(lds + (bo) + kdst + 32 * KP) = kreg1; \
        *(ATT_LAS u32x4*)(lds + (bo) + vdst) = vreg0; *(ATT_LAS u32x4*)(lds + (bo) + vdst + 2048) = vreg1; } while (0)

    f32x16 O[NMAP][4];
#pragma unroll
    for (int c = 0; c < NMAP; ++c)
#pragma unroll
        for (int k = 0; k < 4; ++k)
#pragma unroll
            for (int i = 0; i < 16; ++i) O[c][k][i] = 0.f;
    float mref[NMAP], lsum[NMAP];
#pragma unroll
    for (int c = 0; c < NMAP; ++c) { mref[c] = -1e30f; lsum[c] = 0.f; }

    const int krd = r * KP + 16 * hh;
    const int vrd = KIMG + ((lane >> 4) & 1) * 32 + (lane & 3) * 8 + (4 * hh + ((lane & 15) >> 2)) * 64;

    ATT_GLOAD(0); ATT_LWRITE(0);
    __syncthreads();
    for (int t = 0; t < NT; ++t) {
        const int bo = (t & 1) * BUF;
        if (t + 1 < NT) ATT_GLOAD(t + 1);
        if (t <= my_last) {
            const bool diag = (t == my_last);
            float hc = hc0; asm volatile("" : "+v"(hc));
#pragma unroll
            for (int c = 0; c < NMAP; ++c) {
                if constexpr (!RET) {
#pragma unroll
                    for (int s = 0; s < 4; ++s) qf[s] = *(const ATT_LAS bf16x8*)(lds + qpark + (c * 4 + s) * 1024);
                }
#pragma unroll
                for (int kb = 0; kb < 2; ++kb) {
                    if (kb == 1 && diag && !(q0w & 32)) continue;
                    const int ql = q0w + r - 64 * t - 4 * hh - 32 * kb;
                    f32x16 sa;
#pragma unroll
                    for (int i = 0; i < 16; ++i) sa[i] = 0.f;
#pragma unroll
                    for (int s = 0; s < 4; ++s) { const bf16x8 kf = *(const ATT_LAS bf16x8*)(lds + bo + krd + kb * 32 * KP + c * 128 + s * 32);
                        sa = ATT_MFMA(kf, qf[s], sa); }
                    if constexpr (!RET) {
                        const float lanec = -hc * (float)ql;
#pragma unroll
                        for (int i = 0; i < 16; ++i) sa[i] = __builtin_fmaf(hc, (float)crow0(i), sa[i]);
                        if (diag) {
#pragma unroll
                            for (int i = 0; i < 16; ++i) if (crow0(i) > ql) sa[i] = -1e30f;
                        }
                        float tmax = sa[0];
#pragma unroll
                        for (int i = 1; i < 16; ++i) tmax = fmaxf(tmax, sa[i]);
                        float tm = tmax + lanec; tm = fmaxf(tm, __shfl_xor(tm, 32));
                        if (__any(tm > mref[c] + 8.0f)) {
                            const float mnew = fmaxf(mref[c], tm), alpha = __builtin_amdgcn_exp2f(mref[c] - mnew);
                            lsum[c] *= alpha; mref[c] = mnew;
#pragma unroll
                            for (int k = 0; k < 4; ++k)
#pragma unroll
                                for (int i = 0; i < 16; ++i) O[c][k][i] *= alpha;
                        }
                        const float e = mref[c] - lanec; float ls = 0.f;
#pragma unroll
                        for (int i = 0; i < 16; ++i) { const float p = __builtin_amdgcn_exp2f(sa[i] - e); sa[i] = p; ls += p; }
                        lsum[c] += ls;
                    } else {
                        const float la = hc * (float)ql;
#pragma unroll
                        for (int i = 0; i < 16; ++i) sa[i] = sa[i] * __builtin_amdgcn_exp2f(__builtin_fmaf(-hc, (float)crow0(i), la));
                        if (diag) {
#pragma unroll
                            for (int i = 0; i < 16; ++i) if (crow0(i) > ql) sa[i] = 0.f;
                        }
                    }
                    bf16x8 pf[2];
#pragma unroll
                    for (int s = 0; s < 2; ++s) { u32x4 w;
                        w.x = cvtpk(sa[8 * s + 0], sa[8 * s + 1]); w.y = cvtpk(sa[8 * s + 2], sa[8 * s + 3]);
                        w.z = cvtpk(sa[8 * s + 4], sa[8 * s + 5]); w.w = cvtpk(sa[8 * s + 6], sa[8 * s + 7]);
                        pf[s] = __builtin_bit_cast(bf16x8, w); }
#pragma unroll
                    for (int k = 0; k < 4; ++k)
#pragma unroll
                        for (int s = 0; s < 2; ++s) {
                            const s16x4 lo = vtr(lds + bo + vrd + k * 4096 + (2 * kb + s) * 1024), hi = vtr(lds + bo + vrd + k * 4096 + (2 * kb + s) * 1024 + 512);
                            const bf16x8 vf = __builtin_shufflevector(lo, hi, 0, 1, 2, 3, 4, 5, 6, 7);
                            O[c][k] = ATT_MFMA(vf, pf[s], O[c][k]);
                        }
                }
            }
        }
        if (t + 1 < NT) ATT_LWRITE(((t + 1) & 1) * BUF);
        __syncthreads();
    }
#undef ATT_GLOAD
#undef ATT_LWRITE
    const size_t orow = rowbase + q0w + r;
    if constexpr (!RET) {
        float l1 = lsum[0], l2 = lsum[1];
        l1 += __shfl_xor(l1, 32); l2 += __shfl_xor(l2, 32);
        const float i1 = 1.0f / l1, i2 = lam / l2;
        float ss = 0.f;
#pragma unroll
        for (int k = 0; k < 4; ++k)
#pragma unroll
            for (int i = 0; i < 16; ++i) { const float o = O[0][k][i] * i1 - O[1][k][i] * i2; O[0][k][i] = o; ss += o * o; }
        ss += __shfl_xor(ss, 32);
        const float rn = rsqrtf(ss * (1.0f / 128.0f) + 1e-6f) * omli;
        bf16_t* op = mix + orow * MIXP + h * 128 + 4 * hh;
#pragma unroll
        for (int k = 0; k < 4; ++k)
#pragma unroll
            for (int g = 0; g < 4; ++g) {
                const f32x4 gv = *(const f32x4*)(subln + 32 * k + 8 * g + 4 * hh);
                u32x2 w; w.x = cvtpk(O[0][k][4 * g + 0] * rn * gv[0], O[0][k][4 * g + 1] * rn * gv[1]); w.y = cvtpk(O[0][k][4 * g + 2] * rn * gv[2], O[0][k][4 * g + 3] * rn * gv[3]);
                *(u32x2*)(op + 32 * k + 8 * g) = w;
            }
    } else {
        float ss = 0.f;
#pragma unroll
        for (int k = 0; k < 4; ++k)
#pragma unroll
            for (int i = 0; i < 16; ++i) ss += O[0][k][i] * O[0][k][i];
        ss += __shfl_xor(ss, 32);
        const float rn = rsqrtf(ss * (1.0f / 128.0f) + 1e-6f);
        const bf16_t* gp = proj + orow * PP + 2560 + h * 128 + 4 * hh;
        bf16_t* op = mix + orow * MIXP + 512 + h * 128 + 4 * hh;
#pragma unroll
        for (int k = 0; k < 4; ++k)
#pragma unroll
            for (int g = 0; g < 4; ++g) {
                const u32x2 gw = *(const u32x2*)(gp + 32 * k + 8 * g);
                float gt[4] = {__uint_as_float(gw.x << 16), __uint_as_float(gw.x & 0xffff0000u), __uint_as_float(gw.y << 16), __uint_as_float(gw.y & 0xffff0000u)};
                float ov[4];
#pragma unroll
                for (int j = 0; j < 4; ++j) { const float sg = gt[j] * __builtin_amdgcn_rcpf(1.0f + __builtin_amdgcn_exp2f(-gt[j] * LOG2E)); ov[j] = O[0][k][4 * g + j] * rn * sg; }
                u32x2 w; w.x = cvtpk(ov[0], ov[1]); w.y = cvtpk(ov[2], ov[3]);
                *(u32x2*)(op + 32 * k + 8 * g) = w;
            }
    }
}
}


#ifndef MK_MULTI_LAUNCH
#define MK_MULTI_LAUNCH 0
#endif
#define LAS __attribute__((address_space(3)))
typedef unsigned short bf16;
typedef float f32x4 __attribute__((ext_vector_type(4)));
typedef unsigned v4u __attribute__((ext_vector_type(4)));
typedef unsigned v2u __attribute__((ext_vector_type(2)));

#define XB_TMO      128
#define XB_XCNT(j)  (256  + 64 * (j))
#define XB_XSUB(j)  (1280 + 64 * (j))
#define XB_XGEN(j)  (2304 + 64 * (j))
#define XB_TOP      3328
#define XB_TOPGEN   3392
#define XCD_BAR_WORDS 3456
#define XB_SPIN_CAP (1u << 18)

__device__ __forceinline__ unsigned xb_ld(unsigned* p)              { return __hip_atomic_load(p, __ATOMIC_RELAXED, __HIP_MEMORY_SCOPE_AGENT); }
__device__ __forceinline__ unsigned xb_add(unsigned* p, unsigned v) { return __hip_atomic_fetch_add(p, v, __ATOMIC_RELAXED, __HIP_MEMORY_SCOPE_AGENT); }
__device__ __forceinline__ unsigned xb_xcc_id() { return (unsigned)__builtin_amdgcn_s_getreg((3 << 11) | 20) & 0xFu; }
#define XB_SPIN(cond, bar) do { unsigned _sp = 0; while (cond) { __builtin_amdgcn_s_sleep(1); \
    if ((++_sp & 255u) == 0u) { if (xb_ld(&(bar)[XB_TMO])) break; if (_sp > XB_SPIN_CAP) { atomicAdd(&(bar)[XB_TMO], 1u); break; } } } } while (0)

struct XcdBarrier {
    unsigned* bar; unsigned x;
    volatile LAS unsigned* st;
};

__device__ __forceinline__ XcdBarrier xcd_barrier_post(unsigned* bar, volatile LAS unsigned* st) {
    XcdBarrier b; b.bar = bar; b.x = xb_xcc_id(); b.st = st;
    if (threadIdx.x == 0) (void)xb_add(&bar[XB_XCNT(b.x)], 1u);
    return b;
}
__device__ __forceinline__ void xcd_barrier_complete(unsigned* bar, unsigned x, unsigned& nloc, unsigned& nx) {
    const unsigned G = gridDim.x * gridDim.y * gridDim.z;
    unsigned sum, cnt, mine, sp = 0u;
    for (;;) {
        sum = 0u; cnt = 0u; mine = 0u;
#pragma unroll
        for (unsigned j = 0; j < 16; ++j) { const unsigned c = xb_ld(&bar[XB_XCNT(j)]); sum += c; cnt += (c > 0u) ? 1u : 0u; mine = (j == x) ? c : mine; }
        if (sum == G) break;
        __builtin_amdgcn_s_sleep(1);
        if ((++sp & 255u) == 0u) { if (xb_ld(&bar[XB_TMO])) break; if (sp > XB_SPIN_CAP) { atomicAdd(&bar[XB_TMO], 1u); break; } }
    }
    nloc = mine > 0u ? mine : 1u; nx = cnt > 0u ? cnt : 1u;
}

__device__ __forceinline__ void xcd_barrier(const XcdBarrier& b) {
    asm volatile("s_waitcnt vmcnt(0)" ::: "memory");
    __syncthreads();
    if (threadIdx.x == 0) {
        unsigned* bar = b.bar;
        __builtin_amdgcn_s_waitcnt(0);
        unsigned nloc = b.st[0], nx = b.st[1];
        if (nloc == 0u) { xcd_barrier_complete(bar, b.x, nloc, nx); b.st[0] = nloc; b.st[1] = nx; }
        const unsigned old = xb_add(&bar[XB_XSUB(b.x)], 1u);
        const unsigned gen = old / nloc;
        if (old + 1u == (gen + 1u) * nloc) {
            __builtin_amdgcn_fence(__ATOMIC_RELEASE, "agent");
            asm volatile("s_waitcnt vmcnt(0)" ::: "memory");
            const unsigned og = xb_add(&bar[XB_TOP], 1u);
            const unsigned tg = og / nx;
            if (og + 1u == (tg + 1u) * nx) xb_add(&bar[XB_TOPGEN], 1u);
            else XB_SPIN(xb_ld(&bar[XB_TOPGEN]) == tg, bar);
            __builtin_amdgcn_fence(__ATOMIC_ACQUIRE, "agent");
            xb_add(&bar[XB_XGEN(b.x)], 1u);
            asm volatile("s_waitcnt vmcnt(0)" ::: "memory");
        } else {
            XB_SPIN(xb_ld(&bar[XB_XGEN(b.x)]) == gen, bar);
            __builtin_amdgcn_fence(__ATOMIC_ACQUIRE, "agent");
            asm volatile("s_waitcnt vmcnt(0)" ::: "memory");
        }
    }
    __syncthreads();
}

constexpr int BATCH = 16, SEQ = 2048, D = 1024, DEPTH = 2, FF = 2816, INC = 3072;
constexpr int M = BATCH * SEQ;
constexpr int NPH = 2 + 7 * DEPTH;
constexpr size_t MiB = 1u << 20;
constexpr size_t WS_RSS = 0;
constexpr size_t WS_WFF = 2 * MiB, WFF_SZ = (size_t)2 * FF * D * 2;
constexpr size_t WS_WDN = WS_WFF + 4 * WFF_SZ, WDN_SZ = (size_t)D * FF * 2;
constexpr size_t WS_WIN = WS_WDN + 4 * WDN_SZ, WIN_SZ = (size_t)INC * D * 2;
constexpr size_t WS_WOUT = WS_WIN + 2 * WIN_SZ, WOUT_SZ = (size_t)D * D * 2;
constexpr size_t WS_XB = WS_WOUT + 2 * WOUT_SZ;
constexpr size_t WS_MIX = WS_XB + (size_t)M * D * 2;
constexpr size_t WS_HP = WS_MIX + (size_t)M * D * 2;
constexpr size_t WS_END = WS_HP + (size_t)M * INC * 2;
constexpr size_t WS_CTL = WS_END, CTL_BYTES = 16384;
static_assert(WS_CTL + CTL_BYTES <= 512 * MiB && XCD_BAR_WORDS * 4 <= CTL_BYTES, "d_ws map");
constexpr int LDS_BYTES = 136 * 1024;

struct Args { const float* in[18]; float* out; unsigned char* ws; int ph_lo, ph_hi; };

__device__ __forceinline__ unsigned f2bf(float f) { unsigned u = __builtin_bit_cast(unsigned, f); return (u + 0x7fffu + ((u >> 16) & 1u)) >> 16; }
__device__ __forceinline__ unsigned pk2(float lo, float hi) { return f2bf(lo) | (f2bf(hi) << 16); }
__device__ __forceinline__ float wave_sum(float v) {
#pragma unroll
    for (int o = 1; o < 64; o <<= 1) v += __shfl_xor(v, o);
    return v;
}
__device__ __forceinline__ void tr_item(const float* __restrict__ W, int K, int N, bf16* __restrict__ WT, const float* __restrict__ gain, float cs, int k0, int n0, int drow0, LAS float* scr, int lane) {
#pragma unroll 8
    for (int i = 0; i < 32; ++i) { const int kk = 2 * i + (lane >> 5); const float g = gain ? gain[k0 + kk] * cs : cs;
        scr[kk * 33 + (lane & 31)] = W[(size_t)(k0 + kk) * N + n0 + (lane & 31)] * g; }
    asm volatile("s_waitcnt lgkmcnt(0)" ::: "memory");
    const int c = lane & 7;
#pragma unroll
    for (int j = 0; j < 4; ++j) { const int n = (lane >> 3) + 8 * j; const LAS float* s = scr + (8 * c) * 33 + n;
        v4u o; o.x = pk2(s[0 * 33], s[1 * 33]); o.y = pk2(s[2 * 33], s[3 * 33]); o.z = pk2(s[4 * 33], s[5 * 33]); o.w = pk2(s[6 * 33], s[7 * 33]);
        *(v4u*)(WT + (size_t)(drow0 + n) * K + k0 + 8 * c) = o; }
    asm volatile("s_waitcnt lgkmcnt(0)" ::: "memory");
}

__global__ void __launch_bounds__(512, 2) mega_fwd(Args args) {
    extern __shared__ __attribute__((aligned(16))) unsigned char lds_raw[];
    LAS unsigned char* lds = (LAS unsigned char*)lds_raw;
    cg::grid_group grid = cg::this_grid();
    const int G = gridDim.x, bx = blockIdx.x;
    const int vcu = (G % 8 == 0) ? (bx % 8) * (G / 8) + bx / 8 : bx;
    unsigned char* ws = args.ws;
    float* RSS = (float*)(ws + WS_RSS);
    bf16* XB = (bf16*)(ws + WS_XB); bf16* MIX = (bf16*)(ws + WS_MIX); bf16* HP = (bf16*)(ws + WS_HP);
    float* X = args.out;
    const int lo = args.ph_lo, hi = args.ph_hi;
    volatile LAS unsigned* bst = (volatile LAS unsigned*)(lds + LDS_BYTES - 64);
    if (threadIdx.x < 2) bst[threadIdx.x] = 0u;
    __syncthreads();
    XcdBarrier bar = xcd_barrier_post((unsigned*)(ws + WS_CTL), bst);
#define IN(k) (lo <= (k) && (k) < hi)

#pragma unroll 1
    for (int p = lo; p < hi; ++p) {
    const int pk = (p == 0) ? 7 : (p == NPH - 1) ? 8 : (p - 1) % 7;
    const int l = (p - 1) / 7;
    int tid_ = threadIdx.x; asm volatile("" : "+v"(tid_));
    const int tid = tid_, lane = tid & 63, wave = __builtin_amdgcn_readfirstlane(tid >> 6); (void)tid;
    if (pk == 7) {
        LAS float* scr = (LAS float*)(lds + wave * 16384);
        const int gw = vcu * 8 + wave, NGW = G * 8;
        constexpr int PER_LAYER = 6 * 1408 + 1536 + 512, TOTAL = DEPTH * PER_LAYER;
        for (int g = gw; g < TOTAL; g += NGW) {
            const int ll = g / PER_LAYER; int r = g % PER_LAYER;
            if (r < 4 * 1408) {
                const int m = r / 1408, it = r % 1408, f = m >> 1, up = m & 1;
                const float* W = args.in[f == 0 ? (up ? 3 : 2) : (up ? 15 : 14)] + (size_t)ll * D * FF;
                const float* gain = args.in[f == 0 ? 1 : 13] + ll * D;
                bf16* WT = (bf16*)(ws + WS_WFF + (size_t)(ll * 2 + f) * WFF_SZ);
                const int kb = it / 88, nb = it % 88, n0 = nb * 32;
                tr_item(W, D, FF, WT, gain, 1.0f, kb * 64, n0, 256 * (n0 >> 7) + 128 * up + (n0 & 127), scr, lane);
            } else if (r < 6 * 1408) {
                const int m = r / 1408 - 4, it = r % 1408;
                const float* W = args.in[m == 0 ? 4 : 16] + (size_t)ll * FF * D;
                bf16* WT = (bf16*)(ws + WS_WDN + (size_t)(ll * 2 + m) * WDN_SZ);
                const int kb = it / 32, nb = it % 32;
                tr_item(W, FF, D, WT, nullptr, 1.0f, kb * 64, nb * 32, nb * 32, scr, lane);
            } else if (r < 6 * 1408 + 1536) {
                const int it = r - 6 * 1408, kb = it / 96, nb = it % 96, n0 = nb * 32;
                const float cs = (n0 < 512) ? 0.125f * 1.4426950408889634f : ((n0 >= 1792 && n0 < 2048) ? 0.125f : 1.0f);
                tr_item(args.in[6] + (size_t)ll * D * INC, D, INC, (bf16*)(ws + WS_WIN + (size_t)ll * WIN_SZ), args.in[5] + ll * D, cs, kb * 64, n0, n0, scr, lane);
            } else {
                const int it = r - 6 * 1408 - 1536, kb = it / 32, nb = it % 32;
                tr_item(args.in[12] + (size_t)ll * D * D, D, D, (bf16*)(ws + WS_WOUT + (size_t)ll * WOUT_SZ), nullptr, 1.0f, kb * 64, nb * 32, nb * 32, scr, lane);
            }
        }
        const float* x = args.in[0];
        for (int m = gw; m < M; m += NGW) {
            const f32x4* xr = (const f32x4*)(x + (size_t)m * D) + lane; float s = 0.f;
            v2u* o8 = (v2u*)(XB + (size_t)m * D) + lane;
#pragma unroll
            for (int j = 0; j < 4; ++j) { const f32x4 v = xr[64 * j]; s += (v[0] * v[0] + v[1] * v[1]) + (v[2] * v[2] + v[3] * v[3]);
                v2u w; w.x = pk2(v[0], v[1]); w.y = pk2(v[2], v[3]); o8[64 * j] = w; }
            s = wave_sum(s);
            if (lane < 16) RSS[(size_t)m * 16 + lane] = lane == 0 ? s : 0.f;
        }
    } else if (pk == 0 || pk == 5) {
        const int f = pk == 5;
        pg8::Gemm g{XB, (const bf16*)(ws + WS_WFF + (size_t)(l * 2 + f) * WFF_SZ), M, 2 * FF, D}; pg8::StaticOrder S; S.init(M, 2 * FF, G, bx);
        pg8::EpiSwiglu E{HP, FF, RSS};
        pg8::gemm_phase<pg8::EpiSwiglu, pg8::StaticOrder, true, true>(lds, g, S, E);
    } else if (pk == 2) {
        pg8::Gemm g{XB, (const bf16*)(ws + WS_WIN + (size_t)l * WIN_SZ), M, INC, D}; pg8::StaticOrder S; S.init(M, INC, G, bx);
        pg8::EpiProj E{HP, INC, RSS};
        pg8::gemm_phase<pg8::EpiProj, pg8::StaticOrder, true, true>(lds, g, S, E);
    } else if (pk == 3) {
        const float lam_init = 0.8f - 0.6f * expf(-0.3f * (float)l);
        float s1 = args.in[7][l * 64 + lane] * args.in[8][l * 64 + lane], s2 = args.in[9][l * 64 + lane] * args.in[10][l * 64 + lane];
        s1 = wave_sum(s1); s2 = wave_sum(s2);
        const float lam = expf(s1) - expf(s2) + lam_init;
        const float* subln = args.in[11] + l * 128;
        for (int v = vcu; v < 256; v += G) {
            const int bh = v >> 2, s = v & 3, b = bh >> 2, h = bh & 3;
#pragma unroll 1
            for (int i = 0; i < 2; ++i) att::unit<false>(lds, HP, MIX, b, h, i == 0 ? 7 - s : s, lam, 1.0f - lam_init, subln);
#pragma unroll 1
            for (int i = 0; i < 2; ++i) att::unit<true>(lds, HP, MIX, b, h, i == 0 ? 7 - s : s, 0.f, 0.f, nullptr);
        }
    } else if (pk == 8) {
        const int gw = vcu * 8 + wave, NGW = G * 8;
        const float* gf = args.in[17];
        for (int m = gw; m < M; m += NGW) {
            float s = lane < 16 ? RSS[(size_t)m * 16 + lane] : 0.f; s = wave_sum(s);
            const float rstd = rsqrtf(s * (1.0f / D) + 1e-6f);
            f32x4* xr = (f32x4*)(X + (size_t)m * D) + lane;
#pragma unroll
            for (int j = 0; j < 4; ++j) { const f32x4 gv = ((const f32x4*)gf)[lane + 64 * j]; xr[64 * j] = xr[64 * j] * rstd * gv; }
        }
    } else {
        const bool outp = pk == 4; const int f = pk == 6;
        const bf16* A = outp ? MIX : HP;
        const bf16* Bt = outp ? (const bf16*)(ws + WS_WOUT + (size_t)l * WOUT_SZ) : (const bf16*)(ws + WS_WDN + (size_t)(l * 2 + f) * WDN_SZ);
        pg8::Gemm g{A, Bt, M, D, outp ? D : FF}; pg8::StaticOrder S; S.init(M, D, G, bx);
        pg8::EpiResid E{p == 2 ? args.in[0] : X, X, XB, RSS, outp ? 1.0f : 0.5f};
        pg8::gemm_phase<pg8::EpiResid, pg8::StaticOrder, true, true>(lds, g, S, E);
    }
    if (p + 1 < hi) { if (lo < 0) grid.sync(); else xcd_barrier(bar); }
    }
#undef IN
}

extern "C" void kernel_launch(void* const* d_in, const int* in_sizes, int n_in, void* d_out, int out_size, void* d_ws, size_t ws_size, hipStream_t stream) {
    static int grid = 0;
    if (grid == 0) {
        if (n_in != 18 || out_size != M * D || ws_size < WS_CTL + CTL_BYTES) { fprintf(stderr, "kernel_launch: unexpected shapes (n_in %d out %d ws %zu)\n", n_in, out_size, ws_size); grid = -1; return; }
        int dev = 0, cus = 0, per_cu = 0;
        (void)hipGetDevice(&dev); (void)hipDeviceGetAttribute(&cus, hipDeviceAttributeMultiprocessorCount, dev);
        if (hipFuncSetAttribute((const void*)mega_fwd, hipFuncAttributeMaxDynamicSharedMemorySize, LDS_BYTES) != hipSuccess) { fprintf(stderr, "kernel_launch: hipFuncSetAttribute failed\n"); grid = -1; return; }
        if (hipOccupancyMaxActiveBlocksPerMultiprocessor(&per_cu, (const void*)mega_fwd, 512, LDS_BYTES) != hipSuccess || per_cu < 1) { fprintf(stderr, "kernel_launch: occupancy query says %d\n", per_cu); per_cu = 1; }
        (void)hipGetLastError();
        grid = cus * 1;
        if (grid <= 0) grid = 256;
    }
    if (grid < 0) return;
    (void)hipMemsetAsync((unsigned char*)d_ws + WS_CTL, 0, CTL_BYTES, stream);
    Args a{};
    for (int i = 0; i < 18; ++i) a.in[i] = (const float*)d_in[i];
    a.out = (float*)d_out; a.ws = (unsigned char*)d_ws;
#if MK_MULTI_LAUNCH
    for (int p = 0; p < NPH; ++p) { a.ph_lo = p; a.ph_hi = p + 1; hipLaunchKernelGGL(mega_fwd, dim3(grid), dim3(512), LDS_BYTES, stream, a); }
#else
    a.ph_lo = 0; a.ph_hi = NPH;
    void* kargs[] = {&a};
    hipError_t e = hipLaunchCooperativeKernel((const void*)mega_fwd, dim3(grid), dim3(512), kargs, LDS_BYTES, stream);
    if (e != hipSuccess) fprintf(stderr, "cooperative launch failed: %s (grid %d)\n", hipGetErrorString(e), grid);
#endif
}
```

```cpp
#include <hip/hip_runtime.h>
#include <hip/hip_cooperative_groups.h>
#include <cstdio>
#include <cstdint>
namespace cg = cooperative_groups;
namespace pg8 {
#define PG8_LAS __attribute__((address_space(3)))
typedef unsigned short bf16_t;
typedef short bf16x8 __attribute__((ext_vector_type(8)));
typedef float f32x4 __attribute__((ext_vector_type(4)));
typedef unsigned u32x4 __attribute__((ext_vector_type(4)));
constexpr int BM = 256, BK = 64, HALF = 128, HTB = HALF * BK * 2  , STAGE_BYTES = 8 * HTB, NXCD = 8, WGM = 8;

__host__ __device__ __forceinline__ int lds_byte(int r, int c) { const int st = (r >> 4) * 2 + (c >> 5), rr = r & 15, cc = c & 31, ob = rr * 64 + cc * 2; return st * 1024 + (ob ^ (((ob >> 9) & 1) << 5)); }
__host__ __device__ __forceinline__ void stage_rc(int b, int& R, int& C) { const int st = b / 1024, sb = b % 1024, swz = sb ^ (((sb >> 9) & 1) << 5); R = (st >> 1) * 16 + swz / 64; C = (st & 1) * 32 + (swz % 64) / 2; }
__host__ __device__ __forceinline__ int perm32(int rho) { const int n = rho >> 4, i = rho & 15; return 8 * (i >> 2) + 4 * n + (i & 3); }

struct Unit { int pm, pn; };
struct Gemm { const bf16_t* A; const bf16_t* Bt; int M, N, K; };

struct StaticOrder {
    int nM, nN, nwg, G, c;
    __host__ __device__ void init(int M, int N, int G_, int c_) { nM = M / BM; nN = N / BM; nwg = nM * nN; G = G_; c = c_; }
    __host__ __device__ bool next(int i, Unit& u) const {
        const long L = (long)i * G + c; if (L >= nwg) return false;
        int wgid = (int)L; { const int q = nwg / NXCD, r = nwg % NXCD, xcd = wgid % NXCD, off = wgid / NXCD; wgid = (xcd < r ? xcd * (q + 1) : r * (q + 1) + (xcd - r) * q) + off; }
        const int nig = WGM * nN, gid = wgid / nig, fm = gid * WGM, gsz = (nM - fm) < WGM ? (nM - fm) : WGM;
        u.pm = fm + ((wgid % nig) % gsz); u.pn = (wgid % nig) / gsz; return true;
    }
    __device__ __forceinline__ void a_ready(const Unit&) const {}
    __device__ __forceinline__ void done(const Unit&) const {}
};

typedef unsigned u32x2 __attribute__((ext_vector_type(2)));
#ifndef PEEL_SWI
#define PEEL_SWI true
#endif
#ifndef PEEL_PROJ
#define PEEL_PROJ false
#endif
#ifndef PEEL_RES
#define PEEL_RES false
#endif
__device__ __forceinline__ unsigned cvt_pk_bf16(float lo, float hi) { unsigned r; asm volatile("v_cvt_pk_bf16_f32 %0, %1, %2" : "=v"(r) : "v"(lo), "v"(hi)); return r; }
__device__ __forceinline__ float x16_sum(float v) { auto rr = __builtin_amdgcn_permlane16_swap(__float_as_uint(v), __float_as_uint(v), false, false); return __uint_as_float(rr[0]) + __uint_as_float(rr[1]); }
__device__ __forceinline__ float x32_sum(float v) { auto rr = __builtin_amdgcn_permlane32_swap(__float_as_uint(v), __float_as_uint(v), false, false); return __uint_as_float(rr[0]) + __uint_as_float(rr[1]); }
constexpr float RMS_EPS = 1e-6f;
__device__ __forceinline__ float row_rstd(const float* rss, int row, int fq) {
    const f32x4 v = *(const f32x4*)(rss + (size_t)row * 16 + 4 * fq);
    float s = (v[0] + v[1]) + (v[2] + v[3]);
    s = x32_sum(x16_sum(s));
    return rsqrtf(s * (1.0f / 1024.0f) + RMS_EPS);
}
__device__ __forceinline__ float silu_mul(float g, float u) {
    const float e = __builtin_amdgcn_exp2f(g * -1.4426950408889634f);
    return g * __builtin_amdgcn_rcpf(1.0f + e) * u;
}
__device__ __forceinline__ void row_rstd8(const float* rss, int row0, int fq, float (&r)[8]) {
    f32x4 v[8];
#pragma unroll
    for (int j = 0; j < 8; ++j) v[j] = *(const f32x4*)(rss + (size_t)(row0 + (j >> 2) * HALF + (j & 3) * 16) * 16 + 4 * fq);
#pragma unroll
    for (int j = 0; j < 8; ++j) { float s = (v[j][0] + v[j][1]) + (v[j][2] + v[j][3]); s = x32_sum(x16_sum(s)); r[j] = rsqrtf(s * (1.0f / 1024.0f) + RMS_EPS); }
}
struct EpiSwiglu {
    static constexpr bool PERM = true, AFTER_DRAIN = false; static constexpr int NVM = 8; static constexpr bool PEEL = PEEL_SWI, PRE_PERMUTED = true;
    bf16_t* H; int ldh; const float* rss; mutable float rs[8]; mutable int cpm;
    __device__ __forceinline__ void operator()(const f32x4 (&acc)[2][2][4][2], const Unit& u, int wr, int wc, int fr, int fq) const {
        const int row0 = u.pm * BM + wr * 64 + fr, col0 = u.pn * HALF + wc * 32 + 8 * fq;
        if (u.pm != cpm) { row_rstd8(rss, row0, fq, rs); cpm = u.pm; }
#pragma unroll
        for (int ai = 0; ai < 2; ++ai)
#pragma unroll
            for (int m = 0; m < 4; ++m) {
                const int row = row0 + ai * HALF + m * 16;
                const float r = rs[ai * 4 + m];
                const f32x4 g0 = acc[ai][0][m][0] * r, g1 = acc[ai][0][m][1] * r, u0 = acc[ai][1][m][0] * r, u1 = acc[ai][1][m][1] * r;
                u32x4 w;
                w.x = cvt_pk_bf16(silu_mul(g0[0], u0[0]), silu_mul(g0[1], u0[1])); w.y = cvt_pk_bf16(silu_mul(g0[2], u0[2]), silu_mul(g0[3], u0[3]));
                w.z = cvt_pk_bf16(silu_mul(g1[0], u1[0]), silu_mul(g1[1], u1[1])); w.w = cvt_pk_bf16(silu_mul(g1[2], u1[2]), silu_mul(g1[3], u1[3]));
                *(u32x4*)(H + (size_t)row * ldh + col0) = w;
            }
    }
};
struct EpiProj {
    static constexpr bool PERM = true, AFTER_DRAIN = false; static constexpr int NVM = 16; static constexpr bool PEEL = PEEL_PROJ, PRE_PERMUTED = true;
    bf16_t* O; int ldc; const float* rss; mutable float rs[8]; mutable int cpm;
    __device__ __forceinline__ void operator()(const f32x4 (&acc)[2][2][4][2], const Unit& u, int wr, int wc, int fr, int fq) const {
        const int row0 = u.pm * BM + wr * 64 + fr, col0 = u.pn * BM + wc * 32 + 8 * fq;
        if (u.pm != cpm) { row_rstd8(rss, row0, fq, rs); cpm = u.pm; }
#pragma unroll
        for (int ai = 0; ai < 2; ++ai)
#pragma unroll
            for (int m = 0; m < 4; ++m) {
                const int row = row0 + ai * HALF + m * 16;
                const float r = rs[ai * 4 + m];
                bf16_t* rowp = O + (size_t)row * ldc + col0;
#pragma unroll
                for (int bj = 0; bj < 2; ++bj) {
                    const float rk = (u.pn == 7) ? r * __builtin_amdgcn_exp2f(-__builtin_log2f(1.0f - __builtin_amdgcn_exp2f(-5.0f - (float)(2 * bj + (wc >> 1)))) * (float)(row & 31)) : r;
                    const f32x4 v0 = acc[ai][bj][m][0] * rk, v1 = acc[ai][bj][m][1] * rk;
                    u32x4 w; w.x = cvt_pk_bf16(v0[0], v0[1]); w.y = cvt_pk_bf16(v0[2], v0[3]); w.z = cvt_pk_bf16(v1[0], v1[1]); w.w = cvt_pk_bf16(v1[2], v1[3]);
                    *(u32x4*)(rowp + bj * HALF) = w; }
            }
    }
};
struct EpiResid {
    static constexpr bool PERM = true, AFTER_DRAIN = false; static constexpr int NVM = 16; static constexpr bool PEEL = PEEL_RES, PRE_PERMUTED = true;
    bf16_t* XB; float* rss; float alpha;
    __device__ __forceinline__ void operator()(const f32x4 (&acc)[2][2][4][2], const Unit& u, int wr, int wc, int fr, int fq) const {
        const int row0 = u.pm * BM + wr * 64 + fr, col0 = u.pn * BM + wc * 32 + 8 * fq;
        u32x4 rv[2][2];
#define EPR_LOAD(buf, g) do { const size_t off_ = (size_t)(row0 + ((g) >> 2) * HALF + ((g) & 3) * 16) * 1024 + col0; \
        rv[buf][0] = *(const u32x4*)(XB + off_); rv[buf][1] = *(const u32x4*)(XB + off_ + HALF); } while (0)
        EPR_LOAD(0, 0);
#pragma unroll
        for (int g = 0; g < 8; ++g) {
            const int ai = g >> 2, m = g & 3, cb = g & 1;
            if (g + 1 < 8) EPR_LOAD(cb ^ 1, g + 1);
            const int row = row0 + ai * HALF + m * 16; const size_t off = (size_t)row * 1024 + col0; float ss = 0.f;
#pragma unroll
            for (int bj = 0; bj < 2; ++bj) {
                const u32x4 w = rv[cb][bj];
                f32x4 va, vb;
                va[0] = __uint_as_float(w.x << 16); va[1] = __uint_as_float(w.x & 0xffff0000u); va[2] = __uint_as_float(w.y << 16); va[3] = __uint_as_float(w.y & 0xffff0000u);
                vb[0] = __uint_as_float(w.z << 16); vb[1] = __uint_as_float(w.z & 0xffff0000u); vb[2] = __uint_as_float(w.w << 16); vb[3] = __uint_as_float(w.w & 0xffff0000u);
                va = va + acc[ai][bj][m][0] * alpha; vb = vb + acc[ai][bj][m][1] * alpha;
                ss += (va[0] * va[0] + va[1] * va[1]) + (va[2] * va[2] + va[3] * va[3]) + (vb[0] * vb[0] + vb[1] * vb[1]) + (vb[2] * vb[2] + vb[3] * vb[3]);
                u32x4 o; o.x = cvt_pk_bf16(va[0], va[1]); o.y = cvt_pk_bf16(va[2], va[3]); o.z = cvt_pk_bf16(vb[0], vb[1]); o.w = cvt_pk_bf16(vb[2], vb[3]);
                *(u32x4*)(XB + off + bj * HALF) = o;
            }
            ss = x32_sum(x16_sum(ss));
            if (fq == 0) rss[(size_t)row * 16 + 4 * u.pn + wc] = ss;
        }
#undef EPR_LOAD
    }
};

template <class Epi, class Sched, bool ALIGN_EPI = false, bool SP2 = false, bool PROF = false>
__device__ __forceinline__ void gemm_phase(PG8_LAS unsigned char* lds, const Gemm g, const Sched& S, const Epi& E, unsigned long long* prof = nullptr) {
    unsigned long long pf_t0 = 0, pf_kl = 0, pf_ks = 0; if constexpr (PROF) pf_t0 = __builtin_readcyclecounter();
    int tid_ = threadIdx.x; asm volatile("" : "+v"(tid_));
    const int tid = tid_, wid = __builtin_amdgcn_readfirstlane(tid >> 6), lane = tid & 63, wr = wid >> 2, wc = wid & 3, fr = lane & 15, fq = lane >> 4;
    const int K = g.K, nt = K / BK;
    unsigned voffA, voffB;
    { int R, C; stage_rc(tid * 16, R, C); const int Rb = (Epi::PERM && !Epi::PRE_PERMUTED) ? ((R & ~31) + perm32(R & 31)) : R;
        voffA = (unsigned)(R * K + C) * 2u; voffB = (unsigned)(Rb * K + C) * 2u; }
    const size_t qstep = (size_t)64 * K * 2;
    const size_t kstep = (size_t)(BK * 2);
    const size_t hstep = (size_t)HALF * K * 2;
    const size_t tstep = 2 * hstep;
    const unsigned ldsw = (unsigned)wid * 1024u;
    const int aoff = lds_byte(wr * 64 + fr, fq * 8), boff = lds_byte(wc * 32 + fr, fq * 8);
#define PG8_SA(b, h) (((b) * 2 + (h)) * HTB)
#define PG8_SB(b, h) ((4 + (b) * 2 + (h)) * HTB)
#define PG8_STAGE(bufoff, gbase, voff) do { _Pragma("unroll") for (int _i = 0; _i < 2; ++_i) \
        __builtin_amdgcn_global_load_lds((const unsigned*)((const char*)(gbase) + (size_t)_i * qstep + (voff)), (PG8_LAS unsigned*)(lds + (bufoff) + ldsw + _i * 8192), 16, 0, 0); } while (0)
#define PG8_LDA(dst, b, h) do { _Pragma("unroll") for (int m = 0; m < 4; ++m) _Pragma("unroll") for (int k = 0; k < 2; ++k) dst[m][k] = *(const PG8_LAS bf16x8*)(lds + PG8_SA(b, h) + aoff + m * 2048 + k * 1024); } while (0)
#define PG8_LDB(dst, b, h) do { _Pragma("unroll") for (int n = 0; n < 2; ++n) _Pragma("unroll") for (int k = 0; k < 2; ++k) dst[n][k] = *(const PG8_LAS bf16x8*)(lds + PG8_SB(b, h) + boff + n * 2048 + k * 1024); } while (0)
#define PG8_MMA(ai, bj, At, Bt) do { __builtin_amdgcn_s_setprio(1); _Pragma("unroll") for (int m = 0; m < 4; ++m) _Pragma("unroll") for (int n = 0; n < 2; ++n) _Pragma("unroll") for (int k = 0; k < 2; ++k) \
        acc[ai][bj][m][n] = __builtin_amdgcn_mfma_f32_16x16x32_bf16(Bt[n][k], At[m][k], acc[ai][bj][m][n], 0, 0, 0); __builtin_amdgcn_s_setprio(0); } while (0)
#define PG8_WAIT_V(n) asm volatile("s_waitcnt vmcnt(" #n ")" ::: "memory")
#define PG8_WAIT_L(n) asm volatile("s_waitcnt lgkmcnt(" #n ")" ::: "memory")
#define PG8_BAR __builtin_amdgcn_s_barrier()
#define PG8_WAIT_VE() do { if constexpr (Epi::NVM >= 16) PG8_WAIT_V(24); else PG8_WAIT_V(16); } while (0)
#define PG8_SCHED __builtin_amdgcn_sched_barrier(0)
    Unit cur, nxt; int ui = 0;
    if (!S.next(0, cur)) return;
    f32x4 acc[2][2][4][2];
#pragma unroll
    for (int a = 0; a < 2; ++a)
#pragma unroll
        for (int b = 0; b < 2; ++b)
#pragma unroll
            for (int m = 0; m < 4; ++m)
#pragma unroll
                for (int n = 0; n < 2; ++n) acc[a][b][m][n] = (f32x4){0.f, 0.f, 0.f, 0.f};
    bf16x8 At[4][2], B0[2][2], B1[2][2];
    const char* cA = (const char*)g.A + (size_t)cur.pm * tstep; const char* cB = (const char*)g.Bt + (size_t)cur.pn * tstep;
    S.a_ready(cur);
    if constexpr (SP2) {
        PG8_STAGE(PG8_SB(0, 0), cB, voffB); PG8_STAGE(PG8_SB(0, 1), cB + hstep, voffB); PG8_STAGE(PG8_SA(0, 0), cA, voffA); PG8_STAGE(PG8_SA(0, 1), cA + hstep, voffA);
        if (wr == 1) PG8_BAR;
        PG8_WAIT_V(2); PG8_BAR;
        PG8_STAGE(PG8_SB(1, 0), cB + kstep, voffB); PG8_STAGE(PG8_SA(1, 0), cA + kstep, voffA); PG8_STAGE(PG8_SB(1, 1), cB + hstep + kstep, voffB);
        PG8_WAIT_V(6); PG8_BAR;
    } else {
        PG8_STAGE(PG8_SB(0, 0), cB, voffB); PG8_STAGE(PG8_SA(0, 0), cA, voffA); PG8_STAGE(PG8_SB(0, 1), cB + hstep, voffB); PG8_STAGE(PG8_SA(0, 1), cA + hstep, voffA);
        if (wr == 1) PG8_BAR;
        PG8_WAIT_V(4); PG8_BAR;
        PG8_STAGE(PG8_SB(1, 0), cB + kstep, voffB); PG8_STAGE(PG8_SA(1, 0), cA + kstep, voffA); PG8_STAGE(PG8_SB(1, 1), cB + hstep + kstep, voffB);
        PG8_WAIT_V(6); PG8_BAR;
    }
    for (;;) {
        const bool has_next = S.next(ui + 1, nxt);
        const char* nA = has_next ? (const char*)g.A + (size_t)nxt.pm * tstep : cA; const char* nB = has_next ? (const char*)g.Bt + (size_t)nxt.pn * tstep : cB;
        int t = 0;
        PG8_SCHED;
        if constexpr (SP2 && ALIGN_EPI && Epi::PEEL) { if (ui > 0) {
            if constexpr (PROF) { if (t == 4) pf_ks = __builtin_readcyclecounter(); }
            const bool last = (t == nt - 2);
            const char* a1 = cA + (size_t)(t + 1) * kstep;
            const char* a2 = last ? nA : cA + (size_t)(t + 2) * kstep; const char* b2 = last ? nB : cB + (size_t)(t + 2) * kstep;
            const char* a3 = a2 + kstep; const char* b3 = b2 + kstep;
            if (last && has_next) S.a_ready(nxt);
            PG8_LDB(B0, 0, 0); PG8_LDB(B1, 0, 1); PG8_SCHED; PG8_LDA(At, 0, 0);
            PG8_WAIT_VE(); PG8_WAIT_L(0); PG8_BAR; PG8_MMA(0, 0, At, B0); PG8_MMA(0, 1, At, B1); PG8_BAR; PG8_SCHED;
            PG8_LDA(At, 0, 1); PG8_STAGE(PG8_SB(0, 0), b2, voffB); PG8_STAGE(PG8_SB(0, 1), b2 + hstep, voffB); PG8_STAGE(PG8_SA(0, 0), a2, voffA);
            PG8_WAIT_VE(); PG8_WAIT_L(0); PG8_BAR; PG8_MMA(1, 0, At, B0); PG8_MMA(1, 1, At, B1); PG8_BAR; PG8_SCHED;
            PG8_LDB(B0, 1, 0); PG8_LDB(B1, 1, 1); PG8_SCHED; PG8_LDA(At, 1, 0); PG8_STAGE(PG8_SA(0, 1), a2 + hstep, voffA);
            PG8_WAIT_VE(); PG8_WAIT_L(0); PG8_BAR; PG8_MMA(0, 0, At, B0); PG8_MMA(0, 1, At, B1); PG8_BAR; PG8_SCHED;
            PG8_LDA(At, 1, 1); PG8_STAGE(PG8_SB(1, 0), b3, voffB); PG8_STAGE(PG8_SB(1, 1), b3 + hstep, voffB); PG8_STAGE(PG8_SA(1, 0), a3, voffA);
            PG8_WAIT_V(8); PG8_WAIT_L(0); PG8_BAR; PG8_MMA(1, 0, At, B0); PG8_MMA(1, 1, At, B1); PG8_BAR; PG8_SCHED;
            t = 2;
        } }
        PG8_SCHED;
        for (; t < nt; t += 2) {
            if constexpr (PROF) { if (t == 4) pf_ks = __builtin_readcyclecounter(); }
            const bool last = (t == nt - 2);
            const char* a1 = cA + (size_t)(t + 1) * kstep;
            const char* a2 = last ? nA : cA + (size_t)(t + 2) * kstep; const char* b2 = last ? nB : cB + (size_t)(t + 2) * kstep;
            const char* a3 = a2 + kstep; const char* b3 = b2 + kstep;
            if (last && has_next) S.a_ready(nxt);
            if constexpr (SP2) {
            PG8_LDB(B0, 0, 0); PG8_LDB(B1, 0, 1); PG8_SCHED; PG8_LDA(At, 0, 0); PG8_STAGE(PG8_SA(1, 1), a1 + hstep, voffA);
            PG8_WAIT_V(8); PG8_WAIT_L(0); PG8_BAR; PG8_MMA(0, 0, At, B0); PG8_MMA(0, 1, At, B1); PG8_BAR; PG8_SCHED;
            PG8_LDA(At, 0, 1); PG8_STAGE(PG8_SB(0, 0), b2, voffB); PG8_STAGE(PG8_SB(0, 1), b2 + hstep, voffB); PG8_STAGE(PG8_SA(0, 0), a2, voffA);
            PG8_WAIT_V(8); PG8_WAIT_L(0); PG8_BAR; PG8_MMA(1, 0, At, B0); PG8_MMA(1, 1, At, B1); PG8_BAR; PG8_SCHED;
            PG8_LDB(B0, 1, 0); PG8_LDB(B1, 1, 1); PG8_SCHED; PG8_LDA(At, 1, 0); PG8_STAGE(PG8_SA(0, 1), a2 + hstep, voffA);
            PG8_WAIT_V(8); PG8_WAIT_L(0); PG8_BAR; PG8_MMA(0, 0, At, B0); PG8_MMA(0, 1, At, B1); PG8_BAR; PG8_SCHED;
            PG8_LDA(At, 1, 1); PG8_STAGE(PG8_SB(1, 0), b3, voffB); PG8_STAGE(PG8_SB(1, 1), b3 + hstep, voffB); PG8_STAGE(PG8_SA(1, 0), a3, voffA);
            PG8_WAIT_V(8); PG8_WAIT_L(0); PG8_BAR; PG8_MMA(1, 0, At, B0); PG8_MMA(1, 1, At, B1); PG8_BAR; PG8_SCHED;
            } else {
            PG8_LDB(B0, 0, 0); PG8_SCHED; PG8_LDA(At, 0, 0); PG8_STAGE(PG8_SA(1, 1), a1 + hstep, voffA);
            PG8_WAIT_L(8); PG8_BAR; PG8_WAIT_L(0); PG8_MMA(0, 0, At, B0); PG8_BAR; PG8_SCHED;
            PG8_LDB(B1, 0, 1); PG8_STAGE(PG8_SB(0, 0), b2, voffB);
            PG8_BAR; PG8_WAIT_L(0); PG8_MMA(0, 1, At, B1); PG8_BAR;
            PG8_LDA(At, 0, 1); PG8_STAGE(PG8_SA(0, 0), a2, voffA);
            PG8_BAR; PG8_WAIT_L(0); PG8_MMA(1, 0, At, B0); PG8_BAR; PG8_SCHED;
            PG8_STAGE(PG8_SB(0, 1), b2 + hstep, voffB);
            PG8_WAIT_V(6); PG8_BAR; PG8_MMA(1, 1, At, B1); PG8_BAR;
            PG8_LDB(B0, 1, 0); PG8_SCHED; PG8_LDA(At, 1, 0); PG8_STAGE(PG8_SA(0, 1), a2 + hstep, voffA);
            PG8_WAIT_L(8); PG8_BAR; PG8_WAIT_L(0); PG8_MMA(0, 0, At, B0); PG8_BAR; PG8_SCHED;
            PG8_LDB(B1, 1, 1); PG8_STAGE(PG8_SB(1, 0), b3, voffB);
            PG8_BAR; PG8_WAIT_L(0); PG8_MMA(0, 1, At, B1); PG8_BAR;
            PG8_LDA(At, 1, 1); PG8_STAGE(PG8_SA(1, 0), a3, voffA);
            PG8_BAR; PG8_WAIT_L(0); PG8_MMA(1, 0, At, B0); PG8_BAR; PG8_SCHED;
            PG8_STAGE(PG8_SB(1, 1), b3 + hstep, voffB);
            PG8_WAIT_V(6); PG8_BAR; PG8_MMA(1, 1, At, B1); PG8_BAR;
            }
        }
        if constexpr (PROF) pf_kl += __builtin_readcyclecounter() - pf_ks;
        if constexpr (ALIGN_EPI) { if (wr == 0) PG8_BAR; }
        if constexpr (ALIGN_EPI && SP2 && Epi::PEEL) { if (has_next) PG8_STAGE(PG8_SA(1, 1), nA + kstep + hstep, voffA); }
        if constexpr (!Epi::AFTER_DRAIN) { E(acc, cur, wr, wc, fr, fq); S.done(cur); }
        if (!has_next) break;
#pragma unroll
        for (int a = 0; a < 2; ++a)
#pragma unroll
            for (int b = 0; b < 2; ++b)
#pragma unroll
                for (int m = 0; m < 4; ++m)
#pragma unroll
                    for (int n = 0; n < 2; ++n) acc[a][b][m][n] = (f32x4){0.f, 0.f, 0.f, 0.f};
        cur = nxt; cA = nA; cB = nB; ++ui;
        if constexpr (ALIGN_EPI) { if (wr == 1) PG8_BAR; }
    }
    PG8_WAIT_V(0);
    if constexpr (!ALIGN_EPI) { if (wr == 0) PG8_BAR; }
    PG8_BAR;
    if constexpr (Epi::AFTER_DRAIN) { E.fused(acc, cur, wr, wc, fr, fq, lds, wid, lane); S.done(cur); }
    if constexpr (PROF) { if (prof && blockIdx.x == 0 && tid == 0) { prof[0] = pf_kl; prof[1] = __builtin_readcyclecounter() - pf_t0; } }
#undef PG8_SA
#undef PG8_SB
#undef PG8_STAGE
#undef PG8_LDA
#undef PG8_LDB
#undef PG8_MMA
#undef PG8_WAIT_V
#undef PG8_WAIT_L
#undef PG8_BAR
#undef PG8_WAIT_VE
#undef PG8_SCHED
}
}

namespace att {
#define ATT_LAS __attribute__((address_space(3)))
typedef unsigned short bf16_t;
typedef short bf16x8 __attribute__((ext_vector_type(8)));
typedef short s16x4 __attribute__((ext_vector_type(4)));
typedef float f32x16 __attribute__((ext_vector_type(16)));
typedef float f32x4 __attribute__((ext_vector_type(4)));
typedef unsigned u32x4 __attribute__((ext_vector_type(4)));
typedef unsigned u32x2 __attribute__((ext_vector_type(2)));
constexpr int SEQ = 2048, PP = 3072, MIXP = 1024;
constexpr float LOG2E = 1.4426950408889634f;
#define ATT_MFMA(a, b, c) __builtin_amdgcn_mfma_f32_32x32x16_bf16((a), (b), (c), 0, 0, 0)
__device__ __forceinline__ constexpr int crow0(int i) { return (i & 3) + 8 * (i >> 2); }
__device__ __forceinline__ unsigned cvtpk(float lo, float hi) { typedef float f2 __attribute__((ext_vector_type(2))); typedef __bf16 b2 __attribute__((ext_vector_type(2)));
    f2 v = {lo, hi}; b2 b = __builtin_convertvector(v, b2); return __builtin_bit_cast(unsigned, b); }
__device__ __forceinline__ s16x4 vtr(const ATT_LAS unsigned char* p) { typedef short v4i16_t __attribute__((ext_vector_type(4)));
    return __builtin_bit_cast(s16x4, __builtin_amdgcn_ds_read_tr16_b64_v4i16((ATT_LAS v4i16_t*)p)); }
__device__ __forceinline__ float xhalf_max(float v) { auto rr = __builtin_amdgcn_permlane32_swap(__float_as_uint(v), __float_as_uint(v), false, false); return fmaxf(__uint_as_float(rr[0]), __uint_as_float(rr[1])); }
__device__ __forceinline__ float xhalf_sum(float v) { auto rr = __builtin_amdgcn_permlane32_swap(__float_as_uint(v), __float_as_uint(v), false, false); return __uint_as_float(rr[0]) + __uint_as_float(rr[1]); }
__device__ __forceinline__ float bf2f(unsigned short b) { return __uint_as_float((unsigned)b << 16); }

template <bool RET>
__device__ __forceinline__ void unit(ATT_LAS unsigned char* lds, const bf16_t* __restrict__ proj, bf16_t* __restrict__ mix, int b, int h, int qb,
                                     float lam, float omli  , const float* __restrict__ subln) {
    constexpr int NMAP = RET ? 1 : 2;
    constexpr int KW = RET ? 64 : 128;
    constexpr int KP = KW * 2 + 16;
    constexpr int KIMG = 64 * KP, VIMG = 16384, BUF = KIMG + VIMG;
    constexpr int QOFF = 2 * BUF;
    constexpr int QCOL = RET ? 1536 : 0, KCOL = RET ? 1792 : 512, VCOL = RET ? 2048 : 1024;
    int tid_ = threadIdx.x; asm volatile("" : "+v"(tid_));
    const int tid = tid_, lane = tid & 63, r = lane & 31, hh = lane >> 5;
    const int wid = __builtin_amdgcn_readfirstlane(tid >> 6);
    const size_t rowbase = (size_t)b * SEQ;
    const int q0w = qb * 256 + wid * 32;
    const int NT = 4 * (qb + 1);
    const int my_last = (q0w + 31) >> 6;
    const float hc0 = RET ? __builtin_log2f(1.0f - __builtin_exp2f(-5.0f - (float)h)) : __builtin_exp2f(-2.0f * (float)(h + 1)) * LOG2E;

    bf16x8 qf[4];
    const int qpark = QOFF + wid * 8192 + lane * 16;
    { const bf16_t* qp = proj + (rowbase + q0w + r) * PP + QCOL + h * KW + 8 * hh;
#pragma unroll
      for (int c = 0; c < NMAP; ++c)
#pragma unroll
          for (int s = 0; s < 4; ++s) { const bf16x8 v = *(const bf16x8*)(qp + c * 64 + 16 * s);
              if constexpr (RET) qf[s] = v; else *(ATT_LAS bf16x8*)(lds + qpark + (c * 4 + s) * 1024) = v; } }

    const char* pbase = (const char*)(proj + rowbase * PP);
    const int vkey = tid >> 4, vc = tid & 15;
    const unsigned voff = (unsigned)(vkey * PP + h * 128 + vc * 8) * 2u;
    const int vdst = KIMG + (vc >> 2) * 4096 + vkey * 64 + (vc & 3) * 16;
    const int kkey = RET ? (tid >> 3) : (tid >> 4), kc = RET ? (tid & 7) : (tid & 15);
    const unsigned koff = (unsigned)(kkey * PP + h * KW + kc * 8) * 2u;
    const int kdst = kkey * KP + kc * 16;
    u32x4 kreg0, kreg1, vreg0, vreg1;
#define ATT_GLOAD(t) do { const char* tb_ = pbase + (size_t)(t) * (64 * PP * 2); \
        kreg0 = *(const u32x4*)(tb_ + KCOL * 2 + koff); if constexpr (!RET) kreg1 = *(const u32x4*)(tb_ + KCOL * 2 + 32 * PP * 2 + koff); \
        vreg0 = *(const u32x4*)(tb_ + VCOL * 2 + voff); vreg1 = *(const u32x4*)(tb_ + VCOL * 2 + 32 * PP * 2 + voff); } while (0)
#define ATT_LWRITE(bo) do { *(ATT_LAS u32x4*)(lds + (bo) + kdst) = kreg0; if constexpr (!RET) *(ATT_LAS u32x4*)(lds + (bo) + kdst + 32 * KP) = kreg1; \
        *(ATT_LAS u32x4*)(lds + (bo) + vdst) = vreg0; *(ATT_LAS u32x4*)(lds + (bo) + vdst + 2048) = vreg1; } while (0)

    f32x16 O[NMAP][4];
#pragma unroll
    for (int c = 0; c < NMAP; ++c)
#pragma unroll
        for (int k = 0; k < 4; ++k)
#pragma unroll
            for (int i = 0; i < 16; ++i) O[c][k][i] = 0.f;
    float mref[NMAP], lsum[NMAP];
#pragma unroll
    for (int c = 0; c < NMAP; ++c) { mref[c] = -1e30f; lsum[c] = 0.f; }

    f32x16 cb;
#pragma unroll
    for (int i = 0; i < 16; ++i) cb[i] = RET ? 0.f : hc0 * (float)crow0(i);
    const int krd = r * KP + 16 * hh;
    const int vrd = KIMG + ((lane >> 4) & 1) * 32 + (lane & 3) * 8 + (4 * hh + ((lane & 15) >> 2)) * 64;

    ATT_GLOAD(0); ATT_LWRITE(0);
    __syncthreads();
    for (int t = 0; t < NT; ++t) {
        const int bo = (t & 1) * BUF;
        if (t + 1 < NT) ATT_GLOAD(t + 1);
        if (t <= my_last) {
            const bool diag = (t == my_last);
            float hc = hc0; asm volatile("" : "+v"(hc));
#pragma unroll
            for (int kb = 0; kb < 2; ++kb) {
                if (kb == 1 && diag && !(q0w & 32)) continue;
                const int ql = q0w + r - 64 * t - 4 * hh - 32 * kb;
                bf16x8 pf[NMAP][2];
#pragma unroll
                for (int c = 0; c < NMAP; ++c) {
                    if constexpr (!RET) {
#pragma unroll
                        for (int s = 0; s < 4; ++s) qf[s] = *(const ATT_LAS bf16x8*)(lds + qpark + (c * 4 + s) * 1024);
                    }
                    f32x16 sa;
                    if constexpr (RET) {
#pragma unroll
                        for (int i = 0; i < 16; ++i) sa[i] = 0.f;
                    } else sa = cb;
#pragma unroll
                    for (int s = 0; s < 4; ++s) { const bf16x8 kf = *(const ATT_LAS bf16x8*)(lds + bo + krd + kb * 32 * KP + c * 128 + s * 32);
                        sa = ATT_MFMA(kf, qf[s], sa); }
                    if constexpr (!RET) {
                        const float lanec = -hc * (float)ql;
                        if (diag) {
#pragma unroll
                            for (int i = 0; i < 16; ++i) if (crow0(i) > ql) sa[i] = -1e30f;
                        }
                        float tmax = sa[0];
#pragma unroll
                        for (int i = 1; i < 16; ++i) tmax = fmaxf(tmax, sa[i]);
                        float tm = xhalf_max(tmax + lanec);
                        if (__any(tm > mref[c] + 8.0f)) {
                            const float mnew = fmaxf(mref[c], tm), alpha = __builtin_amdgcn_exp2f(mref[c] - mnew);
                            lsum[c] *= alpha; mref[c] = mnew;
#pragma unroll
                            for (int k = 0; k < 4; ++k)
#pragma unroll
                                for (int i = 0; i < 16; ++i) O[c][k][i] *= alpha;
                        }
                        const float e = mref[c] - lanec; float ls = 0.f;
#pragma unroll
                        for (int i = 0; i < 16; ++i) { const float p = __builtin_amdgcn_exp2f(sa[i] - e); sa[i] = p; ls += p; }
                        lsum[c] += ls;
                    } else {
                        const float rf = __builtin_amdgcn_exp2f(hc * (float)(q0w + r - 64 * t - 32 * kb));
#pragma unroll
                        for (int i = 0; i < 16; ++i) sa[i] = sa[i] * rf;
                        if (diag) {
#pragma unroll
                            for (int i = 0; i < 16; ++i) if (crow0(i) > ql) sa[i] = 0.f;
                        }
                    }
#pragma unroll
                    for (int s = 0; s < 2; ++s) { u32x4 w;
                        w.x = cvtpk(sa[8 * s + 0], sa[8 * s + 1]); w.y = cvtpk(sa[8 * s + 2], sa[8 * s + 3]);
                        w.z = cvtpk(sa[8 * s + 4], sa[8 * s + 5]); w.w = cvtpk(sa[8 * s + 6], sa[8 * s + 7]);
                        pf[c][s] = __builtin_bit_cast(bf16x8, w); }
                }
#pragma unroll
                for (int k = 0; k < 4; ++k)
#pragma unroll
                    for (int s = 0; s < 2; ++s) {
                        const s16x4 lo = vtr(lds + bo + vrd + k * 4096 + (2 * kb + s) * 1024), hi = vtr(lds + bo + vrd + k * 4096 + (2 * kb + s) * 1024 + 512);
                        const bf16x8 vf = __builtin_shufflevector(lo, hi, 0, 1, 2, 3, 4, 5, 6, 7);
#pragma unroll
                        for (int c = 0; c < NMAP; ++c) O[c][k] = ATT_MFMA(vf, pf[c][s], O[c][k]);
                    }
            }
        }
        if (t + 1 < NT) ATT_LWRITE(((t + 1) & 1) * BUF);
        __syncthreads();
    }
#undef ATT_GLOAD
#undef ATT_LWRITE
    const size_t orow = rowbase + q0w + r;
#define ATT_SWAP(a_, b_) __builtin_amdgcn_permlane32_swap((a_), (b_), false, false)
    if constexpr (!RET) {
        float l1 = lsum[0], l2 = lsum[1];
        l1 = xhalf_sum(l1); l2 = xhalf_sum(l2);
        const float i1 = 1.0f / l1, i2 = lam / l2;
        float ss = 0.f;
#pragma unroll
        for (int k = 0; k < 4; ++k)
#pragma unroll
            for (int i = 0; i < 16; ++i) { const float o = O[0][k][i] * i1 - O[1][k][i] * i2; O[0][k][i] = o; ss += o * o; }
        ss = xhalf_sum(ss);
        const float rn = rsqrtf(ss * (1.0f / 128.0f) + 1e-6f);
        bf16_t* op = mix + orow * MIXP + h * 128 + 8 * hh;
#pragma unroll
        for (int k = 0; k < 4; ++k)
#pragma unroll
            for (int gp = 0; gp < 4; gp += 2) {
                u32x2 wg[2];
#pragma unroll
                for (int e = 0; e < 2; ++e) { const int g = gp + e;
                    wg[e].x = cvtpk(O[0][k][4 * g + 0] * rn, O[0][k][4 * g + 1] * rn); wg[e].y = cvtpk(O[0][k][4 * g + 2] * rn, O[0][k][4 * g + 3] * rn); }
                const auto s1 = ATT_SWAP(wg[0].x, wg[1].x), s2 = ATT_SWAP(wg[0].y, wg[1].y);
                u32x4 o; o.x = s1[0]; o.y = s2[0]; o.z = s1[1]; o.w = s2[1];
                *(u32x4*)(op + 32 * k + 8 * gp) = o;
            }
    } else {
        float ss = 0.f;
#pragma unroll
        for (int k = 0; k < 4; ++k)
#pragma unroll
            for (int i = 0; i < 16; ++i) ss += O[0][k][i] * O[0][k][i];
        ss = xhalf_sum(ss);
        const float rn = rsqrtf(ss * (1.0f / 128.0f) + 1e-6f);
        const bf16_t* gp_ = proj + orow * PP + 2560 + h * 128 + 8 * hh;
        bf16_t* op = mix + orow * MIXP + 512 + h * 128 + 8 * hh;
#pragma unroll
        for (int k = 0; k < 4; ++k)
#pragma unroll
            for (int gp = 0; gp < 4; gp += 2) {
                const u32x4 L = *(const u32x4*)(gp_ + 32 * k + 8 * gp);
                const auto t1 = ATT_SWAP(L.x, L.z), t2 = ATT_SWAP(L.y, L.w);
                u32x2 wg[2];
#pragma unroll
                for (int e = 0; e < 2; ++e) { const int g = gp + e; const unsigned gx = t1[e], gy = t2[e];
                    float gt[4] = {__uint_as_float(gx << 16), __uint_as_float(gx & 0xffff0000u), __uint_as_float(gy << 16), __uint_as_float(gy & 0xffff0000u)};
                    float ov[4];
#pragma unroll
                    for (int j = 0; j < 4; ++j) { const float sg = gt[j] * __builtin_amdgcn_rcpf(1.0f + __builtin_amdgcn_exp2f(-gt[j] * LOG2E)); ov[j] = O[0][k][4 * g + j] * rn * sg; }
                    wg[e].x = cvtpk(ov[0], ov[1]); wg[e].y = cvtpk(ov[2], ov[3]); }
                const auto s1 = ATT_SWAP(wg[0].x, wg[1].x), s2 = ATT_SWAP(wg[0].y, wg[1].y);
                u32x4 o; o.x = s1[0]; o.y = s2[0]; o.z = s1[1]; o.w = s2[1];
                *(u32x4*)(op + 32 * k + 8 * gp) = o;
            }
    }
#undef ATT_SWAP
}
}


#ifndef MK_MULTI_LAUNCH
#define MK_MULTI_LAUNCH 0
#endif
#define LAS __attribute__((address_space(3)))
typedef unsigned short bf16;
typedef float f32x4 __attribute__((ext_vector_type(4)));
typedef unsigned v4u __attribute__((ext_vector_type(4)));
typedef unsigned v2u __attribute__((ext_vector_type(2)));

#define XB_TMO      128
#define XB_XCNT(j)  (256  + 64 * (j))
#define XB_XSUB(j)  (1280 + 64 * (j))
#define XB_XGEN(j)  (2304 + 64 * (j))
#define XB_TOP      3328
#define XB_TOPGEN   3392
#define XCD_BAR_WORDS 3456
#define XB_SPIN_CAP (1u << 18)

__device__ __forceinline__ unsigned xb_ld(unsigned* p)              { return __hip_atomic_load(p, __ATOMIC_RELAXED, __HIP_MEMORY_SCOPE_AGENT); }
__device__ __forceinline__ unsigned xb_add(unsigned* p, unsigned v) { return __hip_atomic_fetch_add(p, v, __ATOMIC_RELAXED, __HIP_MEMORY_SCOPE_AGENT); }
__device__ __forceinline__ unsigned xb_xcc_id() { return (unsigned)__builtin_amdgcn_s_getreg((3 << 11) | 20) & 0xFu; }
#define XB_SPIN(cond, bar) do { unsigned _sp = 0; while (cond) { __builtin_amdgcn_s_sleep(1); \
    if ((++_sp & 255u) == 0u) { if (xb_ld(&(bar)[XB_TMO])) break; if (_sp > XB_SPIN_CAP) { atomicAdd(&(bar)[XB_TMO], 1u); break; } } } } while (0)

struct XcdBarrier {
    unsigned* bar; unsigned x;
    volatile LAS unsigned* st;
};

__device__ __forceinline__ XcdBarrier xcd_barrier_post(unsigned* bar, volatile LAS unsigned* st) {
    XcdBarrier b; b.bar = bar; b.x = xb_xcc_id(); b.st = st;
    if (threadIdx.x == 0) (void)xb_add(&bar[XB_XCNT(b.x)], 1u);
    return b;
}
__device__ __forceinline__ void xcd_barrier_complete(unsigned* bar, unsigned x, unsigned& nloc, unsigned& nx) {
    const unsigned G = gridDim.x * gridDim.y * gridDim.z;
    unsigned sum, cnt, mine, sp = 0u;
    for (;;) {
        sum = 0u; cnt = 0u; mine = 0u;
#pragma unroll
        for (unsigned j = 0; j < 16; ++j) { const unsigned c = xb_ld(&bar[XB_XCNT(j)]); sum += c; cnt += (c > 0u) ? 1u : 0u; mine = (j == x) ? c : mine; }
        if (sum == G) break;
        __builtin_amdgcn_s_sleep(1);
        if ((++sp & 255u) == 0u) { if (xb_ld(&bar[XB_TMO])) break; if (sp > XB_SPIN_CAP) { atomicAdd(&bar[XB_TMO], 1u); break; } }
    }
    nloc = mine > 0u ? mine : 1u; nx = cnt > 0u ? cnt : 1u;
}

__device__ __forceinline__ void xcd_barrier(const XcdBarrier& b) {
    asm volatile("s_waitcnt vmcnt(0)" ::: "memory");
    __syncthreads();
    if (threadIdx.x == 0) {
        unsigned* bar = b.bar;
        __builtin_amdgcn_s_waitcnt(0);
        unsigned nloc = b.st[0], nx = b.st[1];
        if (nloc == 0u) { xcd_barrier_complete(bar, b.x, nloc, nx); b.st[0] = nloc; b.st[1] = nx; }
        const unsigned old = xb_add(&bar[XB_XSUB(b.x)], 1u);
        const unsigned gen = old / nloc;
        if (old + 1u == (gen + 1u) * nloc) {
            __builtin_amdgcn_fence(__ATOMIC_RELEASE, "agent");
            asm volatile("s_waitcnt vmcnt(0)" ::: "memory");
            const unsigned og = xb_add(&bar[XB_TOP], 1u);
            const unsigned tg = og / nx;
            if (og + 1u == (tg + 1u) * nx) xb_add(&bar[XB_TOPGEN], 1u);
            else XB_SPIN(xb_ld(&bar[XB_TOPGEN]) == tg, bar);
            __builtin_amdgcn_fence(__ATOMIC_ACQUIRE, "agent");
            xb_add(&bar[XB_XGEN(b.x)], 1u);
            asm volatile("s_waitcnt vmcnt(0)" ::: "memory");
        } else {
            XB_SPIN(xb_ld(&bar[XB_XGEN(b.x)]) == gen, bar);
            __builtin_amdgcn_fence(__ATOMIC_ACQUIRE, "agent");
            asm volatile("s_waitcnt vmcnt(0)" ::: "memory");
        }
    }
    __syncthreads();
}

constexpr int BATCH = 16, SEQ = 2048, D = 1024, DEPTH = 2, FF = 2816, INC = 3072;
constexpr int M = BATCH * SEQ;
constexpr int NPH = 2 + 7 * DEPTH;
constexpr size_t MiB = 1u << 20;
constexpr size_t WS_RSS = 0;
constexpr size_t WS_WFF = 2 * MiB, WFF_SZ = (size_t)2 * FF * D * 2;
constexpr size_t WS_WDN = WS_WFF + 4 * WFF_SZ, WDN_SZ = (size_t)D * FF * 2;
constexpr size_t WS_WIN = WS_WDN + 4 * WDN_SZ, WIN_SZ = (size_t)INC * D * 2;
constexpr size_t WS_WOUT = WS_WIN + 2 * WIN_SZ, WOUT_SZ = (size_t)D * D * 2;
constexpr size_t WS_XB = WS_WOUT + 2 * WOUT_SZ;
constexpr size_t WS_MIX = WS_XB + (size_t)M * D * 2;
constexpr size_t WS_HP = WS_MIX + (size_t)M * D * 2;
constexpr size_t WS_END = WS_HP + (size_t)M * INC * 2;
constexpr size_t WS_CTL = WS_END, CTL_BYTES = 16384;
static_assert(WS_CTL + CTL_BYTES <= 512 * MiB && XCD_BAR_WORDS * 4 <= CTL_BYTES, "d_ws map");
constexpr int LDS_BYTES = 136 * 1024;

struct Args { const float* in[18]; float* out; unsigned char* ws; int ph_lo, ph_hi; };

__device__ __forceinline__ unsigned f2bf(float f) { unsigned u = __builtin_bit_cast(unsigned, f); return (u + 0x7fffu + ((u >> 16) & 1u)) >> 16; }
__device__ __forceinline__ unsigned pk2(float lo, float hi) { return f2bf(lo) | (f2bf(hi) << 16); }
__device__ __forceinline__ float wave_sum(float v) {
    v += __int_as_float(__builtin_amdgcn_ds_swizzle(__float_as_int(v), (1 << 10) | 0x1f));
    v += __int_as_float(__builtin_amdgcn_ds_swizzle(__float_as_int(v), (2 << 10) | 0x1f));
    v += __int_as_float(__builtin_amdgcn_ds_swizzle(__float_as_int(v), (4 << 10) | 0x1f));
    v += __int_as_float(__builtin_amdgcn_ds_swizzle(__float_as_int(v), (8 << 10) | 0x1f));
    return pg8::x32_sum(pg8::x16_sum(v));
}
__device__ __forceinline__ void tr_item(const float* __restrict__ W, int K, int N, bf16* __restrict__ WT, const float* __restrict__ gain, float cs, int k0, int n0, int drow0, LAS float* scr, int lane) {
    const int c4 = lane & 7, kr = lane >> 3;
    f32x4 v[8]; float g[8];
#pragma unroll
    for (int i = 0; i < 8; ++i) { const int kk = 8 * i + kr; v[i] = *(const f32x4*)(W + (size_t)(k0 + kk) * N + n0 + 4 * c4); g[i] = gain ? gain[k0 + kk] * cs : cs; }
#pragma unroll
    for (int i = 0; i < 8; ++i) { const int kk = 8 * i + kr; LAS float* d = scr + kk * 33 + 4 * c4;
        d[0] = v[i][0] * g[i]; d[1] = v[i][1] * g[i]; d[2] = v[i][2] * g[i]; d[3] = v[i][3] * g[i]; }
    asm volatile("s_waitcnt lgkmcnt(0)" ::: "memory");
    const int c = lane & 7;
#pragma unroll
    for (int j = 0; j < 4; ++j) { const int n = (lane >> 3) + 8 * j; const LAS float* s = scr + (8 * c) * 33 + n;
        v4u o; o.x = pk2(s[0 * 33], s[1 * 33]); o.y = pk2(s[2 * 33], s[3 * 33]); o.z = pk2(s[4 * 33], s[5 * 33]); o.w = pk2(s[6 * 33], s[7 * 33]);
        const int rho = ((n >> 2) & 1) * 16 + ((n >> 3) << 2) + (n & 3);
        *(v4u*)(WT + (size_t)(drow0 + rho) * K + k0 + 8 * c) = o; }
    asm volatile("s_waitcnt lgkmcnt(0)" ::: "memory");
}

__global__ void __launch_bounds__(512, 2) mega_fwd(Args args) {
    extern __shared__ __attribute__((aligned(16))) unsigned char lds_raw[];
    LAS unsigned char* lds = (LAS unsigned char*)lds_raw;
    cg::grid_group grid = cg::this_grid();
    const int G = gridDim.x, bx = blockIdx.x;
    const int vcu = (G % 8 == 0) ? (bx % 8) * (G / 8) + bx / 8 : bx;
    unsigned char* ws = args.ws;
    float* RSS = (float*)(ws + WS_RSS);
    bf16* XB = (bf16*)(ws + WS_XB); bf16* MIX = (bf16*)(ws + WS_MIX); bf16* HP = (bf16*)(ws + WS_HP);
    float* X = args.out;
    const int lo = args.ph_lo, hi = args.ph_hi;
    volatile LAS unsigned* bst = (volatile LAS unsigned*)(lds + LDS_BYTES - 64);
    if (threadIdx.x < 2) bst[threadIdx.x] = 0u;
    __syncthreads();
    XcdBarrier bar = xcd_barrier_post((unsigned*)(ws + WS_CTL), bst);
#define IN(k) (lo <= (k) && (k) < hi)

#ifndef PROF_P
#define PROF_P -1
#endif
#ifndef PROBE_KINDS
#define PROBE_KINDS 0u
#endif
    constexpr int PMUL = PROBE_KINDS ? 2 : 1;
#pragma unroll 1
    for (int pp = lo * PMUL; pp < hi * PMUL; ++pp) {
    const int p = pp / PMUL;
    const int pk = (p == 0) ? 7 : (p == NPH - 1) ? 8 : (p - 1) % 7;
    const int l = (p - 1) / 7;
    if (PMUL > 1 && (pp % PMUL) && !((PROBE_KINDS >> pk) & 1u)) continue;
    int tid_ = threadIdx.x; asm volatile("" : "+v"(tid_));
    const int tid = tid_, lane = tid & 63, wave = __builtin_amdgcn_readfirstlane(tid >> 6); (void)tid;
    if (pk == 7) {
        LAS float* scr = (LAS float*)(lds + wave * 16384);
        const int gw = vcu * 8 + wave, NGW = G * 8;
        constexpr int PER_LAYER = 6 * 1408 + 1536 + 512, TOTAL = DEPTH * PER_LAYER;
        for (int g = gw; g < TOTAL; g += NGW) {
            const int ll = g / PER_LAYER; int r = g % PER_LAYER;
            if (r < 4 * 1408) {
                const int m = r / 1408, it = r % 1408, f = m >> 1, up = m & 1;
                const float* W = args.in[f == 0 ? (up ? 3 : 2) : (up ? 15 : 14)] + (size_t)ll * D * FF;
                const float* gain = args.in[f == 0 ? 1 : 13] + ll * D;
                bf16* WT = (bf16*)(ws + WS_WFF + (size_t)(ll * 2 + f) * WFF_SZ);
                const int kb = it / 88, nb = it % 88, n0 = nb * 32;
                tr_item(W, D, FF, WT, gain, 1.0f, kb * 64, n0, 256 * (n0 >> 7) + 128 * up + (n0 & 127), scr, lane);
            } else if (r < 6 * 1408) {
                const int m = r / 1408 - 4, it = r % 1408;
                const float* W = args.in[m == 0 ? 4 : 16] + (size_t)ll * FF * D;
                bf16* WT = (bf16*)(ws + WS_WDN + (size_t)(ll * 2 + m) * WDN_SZ);
                const int kb = it / 32, nb = it % 32;
                tr_item(W, FF, D, WT, nullptr, 1.0f, kb * 64, nb * 32, nb * 32, scr, lane);
            } else if (r < 6 * 1408 + 1536) {
                const int it = r - 6 * 1408, kb = it / 96, nb = it % 96, n0 = nb * 32;
                const float cs = (n0 < 512) ? 0.125f * 1.4426950408889634f : ((n0 >= 1792 && n0 < 2048) ? 0.125f : 1.0f);
                tr_item(args.in[6] + (size_t)ll * D * INC, D, INC, (bf16*)(ws + WS_WIN + (size_t)ll * WIN_SZ), args.in[5] + ll * D, cs, kb * 64, n0, n0, scr, lane);
            } else {
                const int it = r - 6 * 1408 - 1536, kb = it / 32, nb = it % 32;
                const int k0 = kb * 64; const bool dh = k0 < 512;
                const float* wg = dh ? args.in[11] + ll * 128 + (k0 & 127) - k0 : nullptr;
                const float wcs = dh ? 1.0f - (0.8f - 0.6f * expf(-0.3f * (float)ll)) : 1.0f;
                tr_item(args.in[12] + (size_t)ll * D * D, D, D, (bf16*)(ws + WS_WOUT + (size_t)ll * WOUT_SZ), wg, wcs, k0, nb * 32, nb * 32, scr, lane);
            }
        }
        const float* x = args.in[0];
        for (int m = gw; m < M; m += 2 * NGW) {
            const int m2 = m + NGW;
            const f32x4* xr0 = (const f32x4*)(x + (size_t)m * D) + lane; const f32x4* xr1 = (const f32x4*)(x + (size_t)(m2 < M ? m2 : m) * D) + lane;
            f32x4 v0[4], v1[4];
#pragma unroll
            for (int j = 0; j < 4; ++j) { v0[j] = xr0[64 * j]; v1[j] = xr1[64 * j]; }
            float s0 = 0.f, s1 = 0.f;
            v2u* o0 = (v2u*)(XB + (size_t)m * D) + lane; v2u* o1 = (v2u*)(XB + (size_t)(m2 < M ? m2 : m) * D) + lane;
#pragma unroll
            for (int j = 0; j < 4; ++j) {
                s0 += (v0[j][0] * v0[j][0] + v0[j][1] * v0[j][1]) + (v0[j][2] * v0[j][2] + v0[j][3] * v0[j][3]);
                s1 += (v1[j][0] * v1[j][0] + v1[j][1] * v1[j][1]) + (v1[j][2] * v1[j][2] + v1[j][3] * v1[j][3]);
                v2u w; w.x = pk2(v0[j][0], v0[j][1]); w.y = pk2(v0[j][2], v0[j][3]); o0[64 * j] = w;
                if (m2 < M) { v2u w1; w1.x = pk2(v1[j][0], v1[j][1]); w1.y = pk2(v1[j][2], v1[j][3]); o1[64 * j] = w1; } }
            s0 = wave_sum(s0); s1 = wave_sum(s1);
            if (lane < 16) { RSS[(size_t)m * 16 + lane] = lane == 0 ? s0 : 0.f; if (m2 < M) RSS[(size_t)m2 * 16 + lane] = lane == 0 ? s1 : 0.f; }
        }
    } else if (pk == 0 || pk == 5) {
        const int f = pk == 5;
        pg8::Gemm g{XB, (const bf16*)(ws + WS_WFF + (size_t)(l * 2 + f) * WFF_SZ), M, 2 * FF, D}; pg8::StaticOrder S; S.init(M, 2 * FF, G, bx);
        pg8::EpiSwiglu E{HP, FF, RSS, {0.f, 0.f, 0.f, 0.f, 0.f, 0.f, 0.f, 0.f}, -1};
        if (PROF_P >= 0 && p == PROF_P) pg8::gemm_phase<pg8::EpiSwiglu, pg8::StaticOrder, true, true, true>(lds, g, S, E, (unsigned long long*)(ws + WS_CTL + 15360));
        else pg8::gemm_phase<pg8::EpiSwiglu, pg8::StaticOrder, true, true>(lds, g, S, E);
    } else if (pk == 2) {
        pg8::Gemm g{XB, (const bf16*)(ws + WS_WIN + (size_t)l * WIN_SZ), M, INC, D}; pg8::StaticOrder S; S.init(M, INC, G, bx);
        pg8::EpiProj E{HP, INC, RSS, {0.f, 0.f, 0.f, 0.f, 0.f, 0.f, 0.f, 0.f}, -1};
        pg8::gemm_phase<pg8::EpiProj, pg8::StaticOrder, true, true>(lds, g, S, E);
    } else if (pk == 3) {
        const float lam_init = 0.8f - 0.6f * expf(-0.3f * (float)l);
        float s1 = args.in[7][l * 64 + lane] * args.in[8][l * 64 + lane], s2 = args.in[9][l * 64 + lane] * args.in[10][l * 64 + lane];
        s1 = wave_sum(s1); s2 = wave_sum(s2);
        const float lam = expf(s1) - expf(s2) + lam_init;
        const float* subln = args.in[11] + l * 128;
        for (int v = vcu; v < 256; v += G) {
            const int bh = v >> 2, s = v & 3, b = bh >> 2, h = bh & 3;
#pragma unroll 1
            for (int i = 0; i < 2; ++i) att::unit<false>(lds, HP, MIX, b, h, i == 0 ? 7 - s : s, lam, 1.0f - lam_init, subln);
#pragma unroll 1
            for (int i = 0; i < 2; ++i) att::unit<true>(lds, HP, MIX, b, h, i == 0 ? 7 - s : s, 0.f, 0.f, nullptr);
        }
    } else if (pk == 8) {
        const int gw = vcu * 8 + wave, NGW = G * 8;
        const float* gf = args.in[17];
        for (int m = gw; m < M; m += NGW) {
            float s = lane < 16 ? RSS[(size_t)m * 16 + lane] : 0.f; s = wave_sum(s);
            const float rstd = rsqrtf(s * (1.0f / D) + 1e-6f);
            const v2u* xb = (const v2u*)(XB + (size_t)m * D) + lane;
            f32x4* xr = (f32x4*)(X + (size_t)m * D) + lane;
#pragma unroll
            for (int j = 0; j < 4; ++j) { const v2u w = xb[64 * j]; const f32x4 gv = ((const f32x4*)gf)[lane + 64 * j];
                f32x4 v; v[0] = __uint_as_float(w.x << 16); v[1] = __uint_as_float(w.x & 0xffff0000u); v[2] = __uint_as_float(w.y << 16); v[3] = __uint_as_float(w.y & 0xffff0000u);
                xr[64 * j] = v * rstd * gv; }
        }
        if (PROF_P >= 0) { __syncthreads(); if (bx == 0 && tid == 0) { const unsigned long long* pr = (const unsigned long long*)(ws + WS_CTL + 15360); asm volatile("s_waitcnt vmcnt(0)" ::: "memory"); X[0] = 100.0f * (float)pr[0] / (float)pr[1]; } }
    } else {
        const bool outp = pk == 4; const int f = pk == 6;
        const bf16* A = outp ? MIX : HP;
        const bf16* Bt = outp ? (const bf16*)(ws + WS_WOUT + (size_t)l * WOUT_SZ) : (const bf16*)(ws + WS_WDN + (size_t)(l * 2 + f) * WDN_SZ);
        pg8::Gemm g{A, Bt, M, D, outp ? D : FF}; pg8::StaticOrder S; S.init(M, D, G, bx);
        pg8::EpiResid E{XB, RSS, outp ? 1.0f : 0.5f};
        if (PROF_P >= 0 && p == PROF_P) pg8::gemm_phase<pg8::EpiResid, pg8::StaticOrder, true, true, true>(lds, g, S, E, (unsigned long long*)(ws + WS_CTL + 15360));
        else pg8::gemm_phase<pg8::EpiResid, pg8::StaticOrder, true, true>(lds, g, S, E);
    }
    if (pp + 1 < hi * PMUL) { if (lo < 0) grid.sync(); else xcd_barrier(bar); }
    }
#undef IN
}

extern "C" void kernel_launch(void* const* d_in, const int* in_sizes, int n_in, void* d_out, int out_size, void* d_ws, size_t ws_size, hipStream_t stream) {
    static int grid = 0;
    if (grid == 0) {
        if (n_in != 18 || out_size != M * D || ws_size < WS_CTL + CTL_BYTES) { fprintf(stderr, "kernel_launch: unexpected shapes (n_in %d out %d ws %zu)\n", n_in, out_size, ws_size); grid = -1; return; }
        int dev = 0, cus = 0, per_cu = 0;
        (void)hipGetDevice(&dev); (void)hipDeviceGetAttribute(&cus, hipDeviceAttributeMultiprocessorCount, dev);
        if (hipFuncSetAttribute((const void*)mega_fwd, hipFuncAttributeMaxDynamicSharedMemorySize, LDS_BYTES) != hipSuccess) { fprintf(stderr, "kernel_launch: hipFuncSetAttribute failed\n"); grid = -1; return; }
        if (hipOccupancyMaxActiveBlocksPerMultiprocessor(&per_cu, (const void*)mega_fwd, 512, LDS_BYTES) != hipSuccess || per_cu < 1) { fprintf(stderr, "kernel_launch: occupancy query says %d\n", per_cu); per_cu = 1; }
        (void)hipGetLastError();
        grid = cus * 1;
        if (grid <= 0) grid = 256;
    }
    if (grid < 0) return;
    (void)hipMemsetAsync((unsigned char*)d_ws + WS_CTL, 0, CTL_BYTES, stream);
    Args a{};
    for (int i = 0; i < 18; ++i) a.in[i] = (const float*)d_in[i];
    a.out = (float*)d_out; a.ws = (unsigned char*)d_ws;
#if MK_MULTI_LAUNCH
    for (int p = 0; p < NPH; ++p) { a.ph_lo = p; a.ph_hi = p + 1; hipLaunchKernelGGL(mega_fwd, dim3(grid), dim3(512), LDS_BYTES, stream, a); }
#else
    a.ph_lo = 0; a.ph_hi = NPH;
    void* kargs[] = {&a};
    hipError_t e = hipLaunchCooperativeKernel((const void*)mega_fwd, dim3(grid), dim3(512), kargs, LDS_BYTES, stream);
    if (e != hipSuccess) fprintf(stderr, "cooperative launch failed: %s (grid %d)\n", hipGetErrorString(e), grid);
#endif
}
```

```cpp
#include <hip/hip_runtime.h>
#include <hip/hip_cooperative_groups.h>
#include <cstdio>
#include <cstdint>
namespace cg = cooperative_groups;
namespace pg8 {
#define PG8_LAS __attribute__((address_space(3)))
typedef unsigned short bf16_t;
typedef short bf16x8 __attribute__((ext_vector_type(8)));
typedef float f32x4 __attribute__((ext_vector_type(4)));
typedef unsigned u32x4 __attribute__((ext_vector_type(4)));
constexpr int BM = 256, BK = 64, HALF = 128, HTB = HALF * BK * 2  , STAGE_BYTES = 8 * HTB, NXCD = 8, WGM = 8;

__host__ __device__ __forceinline__ int lds_byte(int r, int c) { const int st = (r >> 4) * 2 + (c >> 5), rr = r & 15, cc = c & 31, ob = rr * 64 + cc * 2; return st * 1024 + (ob ^ (((ob >> 9) & 1) << 5)); }
__host__ __device__ __forceinline__ void stage_rc(int b, int& R, int& C) { const int st = b / 1024, sb = b % 1024, swz = sb ^ (((sb >> 9) & 1) << 5); R = (st >> 1) * 16 + swz / 64; C = (st & 1) * 32 + (swz % 64) / 2; }
__host__ __device__ __forceinline__ int perm32(int rho) { const int n = rho >> 4, i = rho & 15; return 8 * (i >> 2) + 4 * n + (i & 3); }

struct Unit { int pm, pn; };
struct Gemm { const bf16_t* A; const bf16_t* Bt; int M, N, K; };

struct StaticOrder {
    int nM, nN, nwg, G, c;
    __host__ __device__ void init(int M, int N, int G_, int c_) { nM = M / BM; nN = N / BM; nwg = nM * nN; G = G_; c = c_; }
    __host__ __device__ bool next(int i, Unit& u) const {
        const long L = (long)i * G + c; if (L >= nwg) return false;
        int wgid = (int)L; { const int q = nwg / NXCD, r = nwg % NXCD, xcd = wgid % NXCD, off = wgid / NXCD; wgid = (xcd < r ? xcd * (q + 1) : r * (q + 1) + (xcd - r) * q) + off; }
        const int nig = WGM * nN, gid = wgid / nig, fm = gid * WGM, gsz = (nM - fm) < WGM ? (nM - fm) : WGM;
        u.pm = fm + ((wgid % nig) % gsz); u.pn = (wgid % nig) / gsz; return true;
    }
    __device__ __forceinline__ void a_ready(const Unit&) const {}
    __device__ __forceinline__ void done(const Unit&) const {}
};

typedef unsigned u32x2 __attribute__((ext_vector_type(2)));
#ifndef PEEL_SWI
#define PEEL_SWI true
#endif
#ifndef PEEL_PROJ
#define PEEL_PROJ false
#endif
#ifndef PEEL_RES
#define PEEL_RES false
#endif
__device__ __forceinline__ unsigned cvt_pk_bf16(float lo, float hi) { unsigned r; asm volatile("v_cvt_pk_bf16_f32 %0, %1, %2" : "=v"(r) : "v"(lo), "v"(hi)); return r; }
__device__ __forceinline__ float x16_sum(float v) { auto rr = __builtin_amdgcn_permlane16_swap(__float_as_uint(v), __float_as_uint(v), false, false); return __uint_as_float(rr[0]) + __uint_as_float(rr[1]); }
__device__ __forceinline__ float x32_sum(float v) { auto rr = __builtin_amdgcn_permlane32_swap(__float_as_uint(v), __float_as_uint(v), false, false); return __uint_as_float(rr[0]) + __uint_as_float(rr[1]); }
constexpr float RMS_EPS = 1e-6f;
__device__ __forceinline__ float row_rstd(const float* rss, int row, int fq) {
    const f32x4 v = *(const f32x4*)(rss + (size_t)row * 16 + 4 * fq);
    float s = (v[0] + v[1]) + (v[2] + v[3]);
    s = x32_sum(x16_sum(s));
    return rsqrtf(s * (1.0f / 1024.0f) + RMS_EPS);
}
__device__ __forceinline__ float silu_mul(float g, float u) {
    const float e = __builtin_amdgcn_exp2f(g * -1.4426950408889634f);
    return g * __builtin_amdgcn_rcpf(1.0f + e) * u;
}
__device__ __forceinline__ void row_rstd8(const float* rss, int row0, int fq, float (&r)[8]) {
    f32x4 v[8];
#pragma unroll
    for (int j = 0; j < 8; ++j) v[j] = *(const f32x4*)(rss + (size_t)(row0 + (j >> 2) * HALF + (j & 3) * 16) * 16 + 4 * fq);
#pragma unroll
    for (int j = 0; j < 8; ++j) { float s = (v[j][0] + v[j][1]) + (v[j][2] + v[j][3]); s = x32_sum(x16_sum(s)); r[j] = rsqrtf(s * (1.0f / 1024.0f) + RMS_EPS); }
}
struct EpiSwiglu {
    static constexpr bool PERM = true, AFTER_DRAIN = false; static constexpr int NVM = 8; static constexpr bool PEEL = PEEL_SWI, PRE_PERMUTED = true;
    bf16_t* H; int ldh; const float* rss; mutable float rs[8]; mutable int cpm;
    __device__ __forceinline__ void operator()(const f32x4 (&acc)[2][2][4][2], const Unit& u, int wr, int wc, int fr, int fq) const {
        const int row0 = u.pm * BM + wr * 64 + fr, col0 = u.pn * HALF + wc * 32 + 8 * fq;
        if (u.pm != cpm) { row_rstd8(rss, row0, fq, rs); cpm = u.pm; }
#pragma unroll
        for (int ai = 0; ai < 2; ++ai)
#pragma unroll
            for (int m = 0; m < 4; ++m) {
                const int row = row0 + ai * HALF + m * 16;
                const float r = rs[ai * 4 + m];
                const f32x4 g0 = acc[ai][0][m][0] * r, g1 = acc[ai][0][m][1] * r, u0 = acc[ai][1][m][0] * r, u1 = acc[ai][1][m][1] * r;
                u32x4 w;
                w.x = cvt_pk_bf16(silu_mul(g0[0], u0[0]), silu_mul(g0[1], u0[1])); w.y = cvt_pk_bf16(silu_mul(g0[2], u0[2]), silu_mul(g0[3], u0[3]));
                w.z = cvt_pk_bf16(silu_mul(g1[0], u1[0]), silu_mul(g1[1], u1[1])); w.w = cvt_pk_bf16(silu_mul(g1[2], u1[2]), silu_mul(g1[3], u1[3]));
                *(u32x4*)(H + (size_t)row * ldh + col0) = w;
            }
    }
};
struct EpiProj {
    static constexpr bool PERM = true, AFTER_DRAIN = false; static constexpr int NVM = 16; static constexpr bool PEEL = PEEL_PROJ, PRE_PERMUTED = true;
    bf16_t* O; int ldc; const float* rss; mutable float rs[8]; mutable int cpm;
    __device__ __forceinline__ void operator()(const f32x4 (&acc)[2][2][4][2], const Unit& u, int wr, int wc, int fr, int fq) const {
        const int row0 = u.pm * BM + wr * 64 + fr, col0 = u.pn * BM + wc * 32 + 8 * fq;
        if (u.pm != cpm) { row_rstd8(rss, row0, fq, rs); cpm = u.pm; }
#pragma unroll
        for (int ai = 0; ai < 2; ++ai)
#pragma unroll
            for (int m = 0; m < 4; ++m) {
                const int row = row0 + ai * HALF + m * 16;
                const float r = rs[ai * 4 + m];
                bf16_t* rowp = O + (size_t)row * ldc + col0;
#pragma unroll
                for (int bj = 0; bj < 2; ++bj) {
                    const float rk = (u.pn == 7) ? r * __builtin_amdgcn_exp2f(-__builtin_log2f(1.0f - __builtin_amdgcn_exp2f(-5.0f - (float)(2 * bj + (wc >> 1)))) * (float)(row & 31)) : r;
                    const f32x4 v0 = acc[ai][bj][m][0] * rk, v1 = acc[ai][bj][m][1] * rk;
                    u32x4 w; w.x = cvt_pk_bf16(v0[0], v0[1]); w.y = cvt_pk_bf16(v0[2], v0[3]); w.z = cvt_pk_bf16(v1[0], v1[1]); w.w = cvt_pk_bf16(v1[2], v1[3]);
                    *(u32x4*)(rowp + bj * HALF) = w; }
            }
    }
};
struct EpiResid {
    static constexpr bool PERM = true, AFTER_DRAIN = false; static constexpr int NVM = 16; static constexpr bool PEEL = PEEL_RES, PRE_PERMUTED = true;
    bf16_t* XB; float* rss; float alpha;
    __device__ __forceinline__ void operator()(const f32x4 (&acc)[2][2][4][2], const Unit& u, int wr, int wc, int fr, int fq) const {
        const int row0 = u.pm * BM + wr * 64 + fr, col0 = u.pn * BM + wc * 32 + 8 * fq;
        u32x4 rv[2][2];
#define EPR_LOAD(buf, g) do { const size_t off_ = (size_t)(row0 + ((g) >> 2) * HALF + ((g) & 3) * 16) * 1024 + col0; \
        rv[buf][0] = *(const u32x4*)(XB + off_); rv[buf][1] = *(const u32x4*)(XB + off_ + HALF); } while (0)
        EPR_LOAD(0, 0);
#pragma unroll
        for (int g = 0; g < 8; ++g) {
            const int ai = g >> 2, m = g & 3, cb = g & 1;
            if (g + 1 < 8) EPR_LOAD(cb ^ 1, g + 1);
            const int row = row0 + ai * HALF + m * 16; const size_t off = (size_t)row * 1024 + col0; float ss = 0.f;
#pragma unroll
            for (int bj = 0; bj < 2; ++bj) {
                const u32x4 w = rv[cb][bj];
                f32x4 va, vb;
                va[0] = __uint_as_float(w.x << 16); va[1] = __uint_as_float(w.x & 0xffff0000u); va[2] = __uint_as_float(w.y << 16); va[3] = __uint_as_float(w.y & 0xffff0000u);
                vb[0] = __uint_as_float(w.z << 16); vb[1] = __uint_as_float(w.z & 0xffff0000u); vb[2] = __uint_as_float(w.w << 16); vb[3] = __uint_as_float(w.w & 0xffff0000u);
                va = va + acc[ai][bj][m][0] * alpha; vb = vb + acc[ai][bj][m][1] * alpha;
                ss += (va[0] * va[0] + va[1] * va[1]) + (va[2] * va[2] + va[3] * va[3]) + (vb[0] * vb[0] + vb[1] * vb[1]) + (vb[2] * vb[2] + vb[3] * vb[3]);
                u32x4 o; o.x = cvt_pk_bf16(va[0], va[1]); o.y = cvt_pk_bf16(va[2], va[3]); o.z = cvt_pk_bf16(vb[0], vb[1]); o.w = cvt_pk_bf16(vb[2], vb[3]);
                *(u32x4*)(XB + off + bj * HALF) = o;
            }
            ss = x32_sum(x16_sum(ss));
            if (fq == 0) rss[(size_t)row * 16 + 4 * u.pn + wc] = ss;
        }
#undef EPR_LOAD
    }
};

template <class Epi, class Sched, bool ALIGN_EPI = false, bool SP2 = false, bool PROF = false>
__device__ __forceinline__ void gemm_phase(PG8_LAS unsigned char* lds, const Gemm g, const Sched& S, const Epi& E, unsigned long long* prof = nullptr) {
    unsigned long long pf_t0 = 0, pf_kl = 0, pf_ks = 0; if constexpr (PROF) pf_t0 = __builtin_readcyclecounter();
    int tid_ = threadIdx.x; asm volatile("" : "+v"(tid_));
    const int tid = tid_, wid = __builtin_amdgcn_readfirstlane(tid >> 6), lane = tid & 63, wr = wid >> 2, wc = wid & 3, fr = lane & 15, fq = lane >> 4;
    const int K = g.K, nt = K / BK;
    unsigned voffA, voffB;
    { int R, C; stage_rc(tid * 16, R, C); const int Rb = (Epi::PERM && !Epi::PRE_PERMUTED) ? ((R & ~31) + perm32(R & 31)) : R;
        voffA = (unsigned)(R * K + C) * 2u; voffB = (unsigned)(Rb * K + C) * 2u; }
    const size_t qstep = (size_t)64 * K * 2;
    const size_t kstep = (size_t)(BK * 2);
    const size_t hstep = (size_t)HALF * K * 2;
    const size_t tstep = 2 * hstep;
    const unsigned ldsw = (unsigned)wid * 1024u;
    const int aoff = lds_byte(wr * 64 + fr, fq * 8), boff = lds_byte(wc * 32 + fr, fq * 8);
#define PG8_SA(b, h) (((b) * 2 + (h)) * HTB)
#define PG8_SB(b, h) ((4 + (b) * 2 + (h)) * HTB)
#define PG8_STAGE(bufoff, gbase, voff) do { _Pragma("unroll") for (int _i = 0; _i < 2; ++_i) \
        __builtin_amdgcn_global_load_lds((const unsigned*)((const char*)(gbase) + (size_t)_i * qstep + (voff)), (PG8_LAS unsigned*)(lds + (bufoff) + ldsw + _i * 8192), 16, 0, 0); } while (0)
#define PG8_LDA(dst, b, h) do { _Pragma("unroll") for (int m = 0; m < 4; ++m) _Pragma("unroll") for (int k = 0; k < 2; ++k) dst[m][k] = *(const PG8_LAS bf16x8*)(lds + PG8_SA(b, h) + aoff + m * 2048 + k * 1024); } while (0)
#define PG8_LDB(dst, b, h) do { _Pragma("unroll") for (int n = 0; n < 2; ++n) _Pragma("unroll") for (int k = 0; k < 2; ++k) dst[n][k] = *(const PG8_LAS bf16x8*)(lds + PG8_SB(b, h) + boff + n * 2048 + k * 1024); } while (0)
#define PG8_MMA(ai, bj, At, Bt) do { __builtin_amdgcn_s_setprio(1); _Pragma("unroll") for (int m = 0; m < 4; ++m) _Pragma("unroll") for (int n = 0; n < 2; ++n) _Pragma("unroll") for (int k = 0; k < 2; ++k) \
        acc[ai][bj][m][n] = __builtin_amdgcn_mfma_f32_16x16x32_bf16(Bt[n][k], At[m][k], acc[ai][bj][m][n], 0, 0, 0); __builtin_amdgcn_s_setprio(0); } while (0)
#define PG8_WAIT_V(n) asm volatile("s_waitcnt vmcnt(" #n ")" ::: "memory")
#define PG8_WAIT_L(n) asm volatile("s_waitcnt lgkmcnt(" #n ")" ::: "memory")
#define PG8_BAR __builtin_amdgcn_s_barrier()
#define PG8_WAIT_VE() do { if constexpr (Epi::NVM >= 16) PG8_WAIT_V(24); else PG8_WAIT_V(16); } while (0)
#define PG8_SCHED __builtin_amdgcn_sched_barrier(0)
    Unit cur, nxt; int ui = 0;
    if (!S.next(0, cur)) return;
    f32x4 acc[2][2][4][2];
#pragma unroll
    for (int a = 0; a < 2; ++a)
#pragma unroll
        for (int b = 0; b < 2; ++b)
#pragma unroll
            for (int m = 0; m < 4; ++m)
#pragma unroll
                for (int n = 0; n < 2; ++n) acc[a][b][m][n] = (f32x4){0.f, 0.f, 0.f, 0.f};
    bf16x8 At[4][2], B0[2][2], B1[2][2];
    const char* cA = (const char*)g.A + (size_t)cur.pm * tstep; const char* cB = (const char*)g.Bt + (size_t)cur.pn * tstep;
    S.a_ready(cur);
    if constexpr (SP2) {
        PG8_STAGE(PG8_SB(0, 0), cB, voffB); PG8_STAGE(PG8_SB(0, 1), cB + hstep, voffB); PG8_STAGE(PG8_SA(0, 0), cA, voffA); PG8_STAGE(PG8_SA(0, 1), cA + hstep, voffA);
        if (wr == 1) PG8_BAR;
        PG8_WAIT_V(2); PG8_BAR;
        PG8_STAGE(PG8_SB(1, 0), cB + kstep, voffB); PG8_STAGE(PG8_SA(1, 0), cA + kstep, voffA); PG8_STAGE(PG8_SB(1, 1), cB + hstep + kstep, voffB);
        PG8_WAIT_V(6); PG8_BAR;
    } else {
        PG8_STAGE(PG8_SB(0, 0), cB, voffB); PG8_STAGE(PG8_SA(0, 0), cA, voffA); PG8_STAGE(PG8_SB(0, 1), cB + hstep, voffB); PG8_STAGE(PG8_SA(0, 1), cA + hstep, voffA);
        if (wr == 1) PG8_BAR;
        PG8_WAIT_V(4); PG8_BAR;
        PG8_STAGE(PG8_SB(1, 0), cB + kstep, voffB); PG8_STAGE(PG8_SA(1, 0), cA + kstep, voffA); PG8_STAGE(PG8_SB(1, 1), cB + hstep + kstep, voffB);
        PG8_WAIT_V(6); PG8_BAR;
    }
    for (;;) {
        const bool has_next = S.next(ui + 1, nxt);
        const char* nA = has_next ? (const char*)g.A + (size_t)nxt.pm * tstep : cA; const char* nB = has_next ? (const char*)g.Bt + (size_t)nxt.pn * tstep : cB;
        int t = 0;
        PG8_SCHED;
        if constexpr (SP2 && ALIGN_EPI && Epi::PEEL) { if (ui > 0) {
            if constexpr (PROF) { if (t == 4) pf_ks = __builtin_readcyclecounter(); }
            const bool last = (t == nt - 2);
            const char* a1 = cA + (size_t)(t + 1) * kstep;
            const char* a2 = last ? nA : cA + (size_t)(t + 2) * kstep; const char* b2 = last ? nB : cB + (size_t)(t + 2) * kstep;
            const char* a3 = a2 + kstep; const char* b3 = b2 + kstep;
            if (last && has_next) S.a_ready(nxt);
            PG8_LDB(B0, 0, 0); PG8_LDB(B1, 0, 1); PG8_SCHED; PG8_LDA(At, 0, 0);
            PG8_WAIT_VE(); PG8_WAIT_L(0); PG8_BAR; PG8_MMA(0, 0, At, B0); PG8_MMA(0, 1, At, B1); PG8_BAR; PG8_SCHED;
            PG8_LDA(At, 0, 1); PG8_STAGE(PG8_SB(0, 0), b2, voffB); PG8_STAGE(PG8_SB(0, 1), b2 + hstep, voffB); PG8_STAGE(PG8_SA(0, 0), a2, voffA);
            PG8_WAIT_VE(); PG8_WAIT_L(0); PG8_BAR; PG8_MMA(1, 0, At, B0); PG8_MMA(1, 1, At, B1); PG8_BAR; PG8_SCHED;
            PG8_LDB(B0, 1, 0); PG8_LDB(B1, 1, 1); PG8_SCHED; PG8_LDA(At, 1, 0); PG8_STAGE(PG8_SA(0, 1), a2 + hstep, voffA);
            PG8_WAIT_VE(); PG8_WAIT_L(0); PG8_BAR; PG8_MMA(0, 0, At, B0); PG8_MMA(0, 1, At, B1); PG8_BAR; PG8_SCHED;
            PG8_LDA(At, 1, 1); PG8_STAGE(PG8_SB(1, 0), b3, voffB); PG8_STAGE(PG8_SB(1, 1), b3 + hstep, voffB); PG8_STAGE(PG8_SA(1, 0), a3, voffA);
            PG8_WAIT_V(8); PG8_WAIT_L(0); PG8_BAR; PG8_MMA(1, 0, At, B0); PG8_MMA(1, 1, At, B1); PG8_BAR; PG8_SCHED;
            t = 2;
        } }
        PG8_SCHED;
        for (; t < nt; t += 2) {
            if constexpr (PROF) { if (t == 4) pf_ks = __builtin_readcyclecounter(); }
            const bool last = (t == nt - 2);
            const char* a1 = cA + (size_t)(t + 1) * kstep;
            const char* a2 = last ? nA : cA + (size_t)(t + 2) * kstep; const char* b2 = last ? nB : cB + (size_t)(t + 2) * kstep;
            const char* a3 = a2 + kstep; const char* b3 = b2 + kstep;
            if (last && has_next) S.a_ready(nxt);
            if constexpr (SP2) {
            PG8_LDB(B0, 0, 0); PG8_LDB(B1, 0, 1); PG8_SCHED; PG8_LDA(At, 0, 0); PG8_STAGE(PG8_SA(1, 1), a1 + hstep, voffA);
            PG8_WAIT_V(8); PG8_WAIT_L(0); PG8_BAR; PG8_MMA(0, 0, At, B0); PG8_MMA(0, 1, At, B1); PG8_BAR; PG8_SCHED;
            PG8_LDA(At, 0, 1); PG8_STAGE(PG8_SB(0, 0), b2, voffB); PG8_STAGE(PG8_SB(0, 1), b2 + hstep, voffB); PG8_STAGE(PG8_SA(0, 0), a2, voffA);
            PG8_WAIT_V(8); PG8_WAIT_L(0); PG8_BAR; PG8_MMA(1, 0, At, B0); PG8_MMA(1, 1, At, B1); PG8_BAR; PG8_SCHED;
            PG8_LDB(B0, 1, 0); PG8_LDB(B1, 1, 1); PG8_SCHED; PG8_LDA(At, 1, 0); PG8_STAGE(PG8_SA(0, 1), a2 + hstep, voffA);
            PG8_WAIT_V(8); PG8_WAIT_L(0); PG8_BAR; PG8_MMA(0, 0, At, B0); PG8_MMA(0, 1, At, B1); PG8_BAR; PG8_SCHED;
            PG8_LDA(At, 1, 1); PG8_STAGE(PG8_SB(1, 0), b3, voffB); PG8_STAGE(PG8_SB(1, 1), b3 + hstep, voffB); PG8_STAGE(PG8_SA(1, 0), a3, voffA);
            PG8_WAIT_V(8); PG8_WAIT_L(0); PG8_BAR; PG8_MMA(1, 0, At, B0); PG8_MMA(1, 1, At, B1); PG8_BAR; PG8_SCHED;
            } else {
            PG8_LDB(B0, 0, 0); PG8_SCHED; PG8_LDA(At, 0, 0); PG8_STAGE(PG8_SA(1, 1), a1 + hstep, voffA);
            PG8_WAIT_L(8); PG8_BAR; PG8_WAIT_L(0); PG8_MMA(0, 0, At, B0); PG8_BAR; PG8_SCHED;
            PG8_LDB(B1, 0, 1); PG8_STAGE(PG8_SB(0, 0), b2, voffB);
            PG8_BAR; PG8_WAIT_L(0); PG8_MMA(0, 1, At, B1); PG8_BAR;
            PG8_LDA(At, 0, 1); PG8_STAGE(PG8_SA(0, 0), a2, voffA);
            PG8_BAR; PG8_WAIT_L(0); PG8_MMA(1, 0, At, B0); PG8_BAR; PG8_SCHED;
            PG8_STAGE(PG8_SB(0, 1), b2 + hstep, voffB);
            PG8_WAIT_V(6); PG8_BAR; PG8_MMA(1, 1, At, B1); PG8_BAR;
            PG8_LDB(B0, 1, 0); PG8_SCHED; PG8_LDA(At, 1, 0); PG8_STAGE(PG8_SA(0, 1), a2 + hstep, voffA);
            PG8_WAIT_L(8); PG8_BAR; PG8_WAIT_L(0); PG8_MMA(0, 0, At, B0); PG8_BAR; PG8_SCHED;
            PG8_LDB(B1, 1, 1); PG8_STAGE(PG8_SB(1, 0), b3, voffB);
            PG8_BAR; PG8_WAIT_L(0); PG8_MMA(0, 1, At, B1); PG8_BAR;
            PG8_LDA(At, 1, 1); PG8_STAGE(PG8_SA(1, 0), a3, voffA);
            PG8_BAR; PG8_WAIT_L(0); PG8_MMA(1, 0, At, B0); PG8_BAR; PG8_SCHED;
            PG8_STAGE(PG8_SB(1, 1), b3 + hstep, voffB);
            PG8_WAIT_V(6); PG8_BAR; PG8_MMA(1, 1, At, B1); PG8_BAR;
            }
        }
        if constexpr (PROF) pf_kl += __builtin_readcyclecounter() - pf_ks;
        if constexpr (ALIGN_EPI) { if (wr == 0) PG8_BAR; }
        if constexpr (ALIGN_EPI && SP2 && Epi::PEEL) { if (has_next) PG8_STAGE(PG8_SA(1, 1), nA + kstep + hstep, voffA); }
        if constexpr (!Epi::AFTER_DRAIN) { E(acc, cur, wr, wc, fr, fq); S.done(cur); }
        if (!has_next) break;
#pragma unroll
        for (int a = 0; a < 2; ++a)
#pragma unroll
            for (int b = 0; b < 2; ++b)
#pragma unroll
                for (int m = 0; m < 4; ++m)
#pragma unroll
                    for (int n = 0; n < 2; ++n) acc[a][b][m][n] = (f32x4){0.f, 0.f, 0.f, 0.f};
        cur = nxt; cA = nA; cB = nB; ++ui;
        if constexpr (ALIGN_EPI) { if (wr == 1) PG8_BAR; }
    }
    PG8_WAIT_V(0);
    if constexpr (!ALIGN_EPI) { if (wr == 0) PG8_BAR; }
    PG8_BAR;
    if constexpr (Epi::AFTER_DRAIN) { E.fused(acc, cur, wr, wc, fr, fq, lds, wid, lane); S.done(cur); }
    if constexpr (PROF) { if (prof && blockIdx.x == 0 && tid == 0) { prof[0] = pf_kl; prof[1] = __builtin_readcyclecounter() - pf_t0; } }
#undef PG8_SA
#undef PG8_SB
#undef PG8_STAGE
#undef PG8_LDA
#undef PG8_LDB
#undef PG8_MMA
#undef PG8_WAIT_V
#undef PG8_WAIT_L
#undef PG8_BAR
#undef PG8_WAIT_VE
#undef PG8_SCHED
}
}

namespace att {
#define ATT_LAS __attribute__((address_space(3)))
typedef unsigned short bf16_t;
typedef short bf16x8 __attribute__((ext_vector_type(8)));
typedef short s16x4 __attribute__((ext_vector_type(4)));
typedef float f32x16 __attribute__((ext_vector_type(16)));
typedef float f32x4 __attribute__((ext_vector_type(4)));
typedef unsigned u32x4 __attribute__((ext_vector_type(4)));
typedef unsigned u32x2 __attribute__((ext_vector_type(2)));
constexpr int SEQ = 2048, PP = 3072, MIXP = 1024;
constexpr float LOG2E = 1.4426950408889634f;
#define ATT_MFMA(a, b, c) __builtin_amdgcn_mfma_f32_32x32x16_bf16((a), (b), (c), 0, 0, 0)
__device__ __forceinline__ constexpr int crow0(int i) { return (i & 3) + 8 * (i >> 2); }
__device__ __forceinline__ unsigned cvtpk(float lo, float hi) { typedef float f2 __attribute__((ext_vector_type(2))); typedef __bf16 b2 __attribute__((ext_vector_type(2)));
    f2 v = {lo, hi}; b2 b = __builtin_convertvector(v, b2); return __builtin_bit_cast(unsigned, b); }
__device__ __forceinline__ s16x4 vtr(const ATT_LAS unsigned char* p) { typedef short v4i16_t __attribute__((ext_vector_type(4)));
    return __builtin_bit_cast(s16x4, __builtin_amdgcn_ds_read_tr16_b64_v4i16((ATT_LAS v4i16_t*)p)); }
__device__ __forceinline__ float xhalf_max(float v) { auto rr = __builtin_amdgcn_permlane32_swap(__float_as_uint(v), __float_as_uint(v), false, false); return fmaxf(__uint_as_float(rr[0]), __uint_as_float(rr[1])); }
__device__ __forceinline__ float xhalf_sum(float v) { auto rr = __builtin_amdgcn_permlane32_swap(__float_as_uint(v), __float_as_uint(v), false, false); return __uint_as_float(rr[0]) + __uint_as_float(rr[1]); }
__device__ __forceinline__ float bf2f(unsigned short b) { return __uint_as_float((unsigned)b << 16); }

template <bool RET>
__device__ __forceinline__ void unit(ATT_LAS unsigned char* lds, const bf16_t* __restrict__ proj, bf16_t* __restrict__ mix, int b, int h, int qb,
                                     float lam, float omli  , const float* __restrict__ subln) {
    constexpr int NMAP = RET ? 1 : 2;
    constexpr int KW = RET ? 64 : 128;
    constexpr int KP = KW * 2 + 16;
    constexpr int KIMG = 64 * KP, VIMG = 16384, BUF = KIMG + VIMG;
    constexpr int QOFF = 2 * BUF;
    constexpr int QCOL = RET ? 1536 : 0, KCOL = RET ? 1792 : 512, VCOL = RET ? 2048 : 1024;
    int tid_ = threadIdx.x; asm volatile("" : "+v"(tid_));
    const int tid = tid_, lane = tid & 63, r = lane & 31, hh = lane >> 5;
    const int wid = __builtin_amdgcn_readfirstlane(tid >> 6);
    const size_t rowbase = (size_t)b * SEQ;
    const int q0w = qb * 256 + wid * 32;
    const int NT = 4 * (qb + 1);
    const int my_last = (q0w + 31) >> 6;
    const float hc0 = RET ? __builtin_log2f(1.0f - __builtin_exp2f(-5.0f - (float)h)) : __builtin_exp2f(-2.0f * (float)(h + 1)) * LOG2E;

    bf16x8 qf[4];
    const int qpark = QOFF + wid * 8192 + lane * 16;
    { const bf16_t* qp = proj + (rowbase + q0w + r) * PP + QCOL + h * KW + 8 * hh;
#pragma unroll
      for (int c = 0; c < NMAP; ++c)
#pragma unroll
          for (int s = 0; s < 4; ++s) { const bf16x8 v = *(const bf16x8*)(qp + c * 64 + 16 * s);
              if constexpr (RET) qf[s] = v; else *(ATT_LAS bf16x8*)(lds + qpark + (c * 4 + s) * 1024) = v; } }

    const char* pbase = (const char*)(proj + rowbase * PP);
    const int vkey = tid >> 4, vc = tid & 15;
    const unsigned voff = (unsigned)(vkey * PP + h * 128 + vc * 8) * 2u;
    const int vdst = KIMG + (vc >> 2) * 4096 + vkey * 64 + (vc & 3) * 16;
    const int kkey = RET ? (tid >> 3) : (tid >> 4), kc = RET ? (tid & 7) : (tid & 15);
    const unsigned koff = (unsigned)(kkey * PP + h * KW + kc * 8) * 2u;
    const int kdst = kkey * KP + kc * 16;
    u32x4 kreg0, kreg1, vreg0, vreg1;
#define ATT_GLOAD(t) do { const char* tb_ = pbase + (size_t)(t) * (64 * PP * 2); \
        kreg0 = *(const u32x4*)(tb_ + KCOL * 2 + koff); if constexpr (!RET) kreg1 = *(const u32x4*)(tb_ + KCOL * 2 + 32 * PP * 2 + koff); \
        vreg0 = *(const u32x4*)(tb_ + VCOL * 2 + voff); vreg1 = *(const u32x4*)(tb_ + VCOL * 2 + 32 * PP * 2 + voff); } while (0)
#define ATT_LWRITE(bo) do { *(ATT_LAS u32x4*)(lds + (bo) + kdst) = kreg0; if constexpr (!RET) *(ATT_LAS u32x4*)(lds + (bo) + kdst + 32 * KP) = kreg1; \
        *(ATT_LAS u32x4*)(lds + (bo) + vdst) = vreg0; *(ATT_LAS u32x4*)(lds + (bo) + vdst + 2048) = vreg1; } while (0)

    f32x16 O[NMAP][4];
#pragma unroll
    for (int c = 0; c < NMAP; ++c)
#pragma unroll
        for (int k = 0; k < 4; ++k)
#pragma unroll
            for (int i = 0; i < 16; ++i) O[c][k][i] = 0.f;
    float mref[NMAP], lsum[NMAP];
#pragma unroll
    for (int c = 0; c < NMAP; ++c) { mref[c] = -1e30f; lsum[c] = 0.f; }

    f32x16 cb;
#pragma unroll
    for (int i = 0; i < 16; ++i) cb[i] = RET ? 0.f : hc0 * (float)crow0(i);
    const int krd = r * KP + 16 * hh;
    const int vrd = KIMG + ((lane >> 4) & 1) * 32 + (lane & 3) * 8 + (4 * hh + ((lane & 15) >> 2)) * 64;

    ATT_GLOAD(0); ATT_LWRITE(0);
    __syncthreads();
    for (int t = 0; t < NT; ++t) {
        const int bo = (t & 1) * BUF;
        if (t + 1 < NT) ATT_GLOAD(t + 1);
        if (t <= my_last) {
            const bool diag = (t == my_last);
            float hc = hc0; asm volatile("" : "+v"(hc));
#pragma unroll
            for (int kb = 0; kb < 2; ++kb) {
                if (kb == 1 && diag && !(q0w & 32)) continue;
                const int ql = q0w + r - 64 * t - 4 * hh - 32 * kb;
                bf16x8 pf[NMAP][2];
#pragma unroll
                for (int c = 0; c < NMAP; ++c) {
                    if constexpr (!RET) {
#pragma unroll
                        for (int s = 0; s < 4; ++s) qf[s] = *(const ATT_LAS bf16x8*)(lds + qpark + (c * 4 + s) * 1024);
                    }
                    f32x16 sa;
                    if constexpr (RET) {
#pragma unroll
                        for (int i = 0; i < 16; ++i) sa[i] = 0.f;
                    } else sa = cb;
#pragma unroll
                    for (int s = 0; s < 4; ++s) { const bf16x8 kf = *(const ATT_LAS bf16x8*)(lds + bo + krd + kb * 32 * KP + c * 128 + s * 32);
                        sa = ATT_MFMA(kf, qf[s], sa); }
                    if constexpr (!RET) {
                        const float lanec = -hc * (float)ql;
                        if (diag) {
#pragma unroll
                            for (int i = 0; i < 16; ++i) if (crow0(i) > ql) sa[i] = -1e30f;
                        }
                        float tmax = sa[0];
#pragma unroll
                        for (int i = 1; i < 16; ++i) tmax = fmaxf(tmax, sa[i]);
                        float tm = xhalf_max(tmax + lanec);
                        if (__any(tm > mref[c] + 8.0f)) {
                            const float mnew = fmaxf(mref[c], tm), alpha = __builtin_amdgcn_exp2f(mref[c] - mnew);
                            lsum[c] *= alpha; mref[c] = mnew;
#pragma unroll
                            for (int k = 0; k < 4; ++k)
#pragma unroll
                                for (int i = 0; i < 16; ++i) O[c][k][i] *= alpha;
                        }
                        const float e = mref[c] - lanec; float ls = 0.f;
#pragma unroll
                        for (int i = 0; i < 16; ++i) { const float p = __builtin_amdgcn_exp2f(sa[i] - e); sa[i] = p; ls += p; }
                        lsum[c] += ls;
                    } else {
                        const float rf = __builtin_amdgcn_exp2f(hc * (float)(q0w + r - 64 * t - 32 * kb));
#pragma unroll
                        for (int i = 0; i < 16; ++i) sa[i] = sa[i] * rf;
                        if (diag) {
#pragma unroll
                            for (int i = 0; i < 16; ++i) if (crow0(i) > ql) sa[i] = 0.f;
                        }
                    }
#pragma unroll
                    for (int s = 0; s < 2; ++s) { u32x4 w;
                        w.x = cvtpk(sa[8 * s + 0], sa[8 * s + 1]); w.y = cvtpk(sa[8 * s + 2], sa[8 * s + 3]);
                        w.z = cvtpk(sa[8 * s + 4], sa[8 * s + 5]); w.w = cvtpk(sa[8 * s + 6], sa[8 * s + 7]);
                        pf[c][s] = __builtin_bit_cast(bf16x8, w); }
                }
#pragma unroll
                for (int k = 0; k < 4; ++k)
#pragma unroll
                    for (int s = 0; s < 2; ++s) {
                        const s16x4 lo = vtr(lds + bo + vrd + k * 4096 + (2 * kb + s) * 1024), hi = vtr(lds + bo + vrd + k * 4096 + (2 * kb + s) * 1024 + 512);
                        const bf16x8 vf = __builtin_shufflevector(lo, hi, 0, 1, 2, 3, 4, 5, 6, 7);
#pragma unroll
                        for (int c = 0; c < NMAP; ++c) O[c][k] = ATT_MFMA(vf, pf[c][s], O[c][k]);
                    }
            }
        }
        if (t + 1 < NT) ATT_LWRITE(((t + 1) & 1) * BUF);
        __syncthreads();
    }
#undef ATT_GLOAD
#undef ATT_LWRITE
    const size_t orow = rowbase + q0w + r;
#define ATT_SWAP(a_, b_) __builtin_amdgcn_permlane32_swap((a_), (b_), false, false)
    if constexpr (!RET) {
        float l1 = lsum[0], l2 = lsum[1];
        l1 = xhalf_sum(l1); l2 = xhalf_sum(l2);
        const float i1 = 1.0f / l1, i2 = lam / l2;
        float ss = 0.f;
#pragma unroll
        for (int k = 0; k < 4; ++k)
#pragma unroll
            for (int i = 0; i < 16; ++i) { const float o = O[0][k][i] * i1 - O[1][k][i] * i2; O[0][k][i] = o; ss += o * o; }
        ss = xhalf_sum(ss);
        const float rn = rsqrtf(ss * (1.0f / 128.0f) + 1e-6f) * omli;
        bf16_t* op = mix + orow * MIXP + h * 128 + 8 * hh;
#pragma unroll
        for (int k = 0; k < 4; ++k)
#pragma unroll
            for (int gp = 0; gp < 4; gp += 2) {
                u32x2 wg[2];
#pragma unroll
                for (int e = 0; e < 2; ++e) { const int g = gp + e;
                    const f32x4 gv = *(const f32x4*)(subln + 32 * k + 8 * g + 4 * hh);
                    wg[e].x = cvtpk(O[0][k][4 * g + 0] * rn * gv[0], O[0][k][4 * g + 1] * rn * gv[1]); wg[e].y = cvtpk(O[0][k][4 * g + 2] * rn * gv[2], O[0][k][4 * g + 3] * rn * gv[3]); }
                const auto s1 = ATT_SWAP(wg[0].x, wg[1].x), s2 = ATT_SWAP(wg[0].y, wg[1].y);
                u32x4 o; o.x = s1[0]; o.y = s2[0]; o.z = s1[1]; o.w = s2[1];
                *(u32x4*)(op + 32 * k + 8 * gp) = o;
            }
    } else {
        float ss = 0.f;
#pragma unroll
        for (int k = 0; k < 4; ++k)
#pragma unroll
            for (int i = 0; i < 16; ++i) ss += O[0][k][i] * O[0][k][i];
        ss = xhalf_sum(ss);
        const float rn = rsqrtf(ss * (1.0f / 128.0f) + 1e-6f);
        const bf16_t* gp_ = proj + orow * PP + 2560 + h * 128 + 8 * hh;
        bf16_t* op = mix + orow * MIXP + 512 + h * 128 + 8 * hh;
#pragma unroll
        for (int k = 0; k < 4; ++k)
#pragma unroll
            for (int gp = 0; gp < 4; gp += 2) {
                const u32x4 L = *(const u32x4*)(gp_ + 32 * k + 8 * gp);
                const auto t1 = ATT_SWAP(L.x, L.z), t2 = ATT_SWAP(L.y, L.w);
                u32x2 wg[2];
#pragma unroll
                for (int e = 0; e < 2; ++e) { const int g = gp + e; const unsigned gx = t1[e], gy = t2[e];
                    float gt[4] = {__uint_as_float(gx << 16), __uint_as_float(gx & 0xffff0000u), __uint_as_float(gy << 16), __uint_as_float(gy & 0xffff0000u)};
                    float ov[4];
#pragma unroll
                    for (int j = 0; j < 4; ++j) { const float sg = gt[j] * __builtin_amdgcn_rcpf(1.0f + __builtin_amdgcn_exp2f(-gt[j] * LOG2E)); ov[j] = O[0][k][4 * g + j] * rn * sg; }
                    wg[e].x = cvtpk(ov[0], ov[1]); wg[e].y = cvtpk(ov[2], ov[3]); }
                const auto s1 = ATT_SWAP(wg[0].x, wg[1].x), s2 = ATT_SWAP(wg[0].y, wg[1].y);
                u32x4 o; o.x = s1[0]; o.y = s2[0]; o.z = s1[1]; o.w = s2[1];
                *(u32x4*)(op + 32 * k + 8 * gp) = o;
            }
    }
#undef ATT_SWAP
}

__device__ __forceinline__ void unit_rets(ATT_LAS unsigned char* lds, const bf16_t* __restrict__ proj, bf16_t* __restrict__ mix, int b, int h, int qb) {
    constexpr int KP = 64 * 2 + 16, KIMG = 64 * KP, VIMG = 16384, VB0 = 2 * KIMG;
    int tid_ = threadIdx.x; asm volatile("" : "+v"(tid_));
    const int tid = tid_, lane = tid & 63, r = lane & 31, hh = lane >> 5;
    const int wid = __builtin_amdgcn_readfirstlane(tid >> 6);
    const size_t rowbase = (size_t)b * SEQ;
    const int q0w = qb * 256 + wid * 32;
    const int NT = 4 * (qb + 1);
    const int my_last = (q0w + 31) >> 6;
    const float hc = __builtin_log2f(1.0f - __builtin_exp2f(-5.0f - (float)h));
    bf16x8 qf[4];
    { const bf16_t* qp = proj + (rowbase + q0w + r) * PP + 1536 + h * 64 + 8 * hh;
#pragma unroll
      for (int s = 0; s < 4; ++s) qf[s] = *(const bf16x8*)(qp + 16 * s); }
    const char* pbase = (const char*)(proj + rowbase * PP);
    const int vkey = tid >> 4, vc = tid & 15;
    const unsigned voff = (unsigned)(vkey * PP + h * 128 + vc * 8) * 2u;
    const int vdst = (vc >> 2) * 4096 + vkey * 64 + (vc & 3) * 16;
    const int kkey = tid >> 3, kc = tid & 7;
    const unsigned koff = (unsigned)(kkey * PP + h * 64 + kc * 8) * 2u;
    const int kdst = kkey * KP + kc * 16;
    u32x4 kreg0, vreg0, vreg1;
#define ATT_GLOAD(t) do { const char* tb_ = pbase + (size_t)(t) * (64 * PP * 2); \
        kreg0 = *(const u32x4*)(tb_ + 1792 * 2 + koff); vreg0 = *(const u32x4*)(tb_ + 2048 * 2 + voff); vreg1 = *(const u32x4*)(tb_ + 2048 * 2 + 32 * PP * 2 + voff); } while (0)
#define ATT_LWRITE(ko_, vo_) do { *(ATT_LAS u32x4*)(lds + (ko_) + kdst) = kreg0; *(ATT_LAS u32x4*)(lds + (vo_) + vdst) = vreg0; *(ATT_LAS u32x4*)(lds + (vo_) + vdst + 2048) = vreg1; } while (0)
    f32x16 O[4];
#pragma unroll
    for (int k = 0; k < 4; ++k)
#pragma unroll
        for (int i = 0; i < 16; ++i) O[k][i] = 0.f;
    const int krd = r * KP + 16 * hh;
    const int vrd = ((lane >> 4) & 1) * 32 + (lane & 3) * 8 + (4 * hh + ((lane & 15) >> 2)) * 64;
    bf16x8 pf[2];
    pf[0] = (bf16x8){0, 0, 0, 0, 0, 0, 0, 0}; pf[1] = pf[0];
#define ATT_RQKS(t_, kb_, ko_) do { \
        const int ql = q0w + r - 64 * (t_) - 4 * hh - 32 * (kb_); \
        f32x16 sa; _Pragma("unroll") for (int i = 0; i < 16; ++i) sa[i] = 0.f; \
        _Pragma("unroll") for (int s = 0; s < 4; ++s) { const bf16x8 kf = *(const ATT_LAS bf16x8*)(lds + (ko_) + krd + (kb_) * 32 * KP + s * 32); sa = ATT_MFMA(kf, qf[s], sa); } \
        const float rf = __builtin_amdgcn_exp2f(hc * (float)(q0w + r - 64 * (t_) - 32 * (kb_))); \
        _Pragma("unroll") for (int i = 0; i < 16; ++i) sa[i] = sa[i] * rf; \
        if (diag) { _Pragma("unroll") for (int i = 0; i < 16; ++i) if (crow0(i) > ql) sa[i] = 0.f; } \
        _Pragma("unroll") for (int s = 0; s < 2; ++s) { u32x4 w; \
            w.x = cvtpk(sa[8 * s + 0], sa[8 * s + 1]); w.y = cvtpk(sa[8 * s + 2], sa[8 * s + 3]); \
            w.z = cvtpk(sa[8 * s + 4], sa[8 * s + 5]); w.w = cvtpk(sa[8 * s + 6], sa[8 * s + 7]); \
            pf[s] = __builtin_bit_cast(bf16x8, w); } } while (0)
#define ATT_RPV(va_) do { \
        _Pragma("unroll") for (int k = 0; k < 4; ++k) _Pragma("unroll") for (int s = 0; s < 2; ++s) { \
            const s16x4 lo = vtr(lds + (va_) + vrd + k * 4096 + s * 1024), hi = vtr(lds + (va_) + vrd + k * 4096 + s * 1024 + 512); \
            const bf16x8 vf = __builtin_shufflevector(lo, hi, 0, 1, 2, 3, 4, 5, 6, 7); \
            O[k] = ATT_MFMA(vf, pf[s], O[k]); } } while (0)
    ATT_GLOAD(0); ATT_LWRITE(0, VB0);
    __syncthreads();
    int ko = 0, vo = VB0, vn = VB0 + VIMG, vp = VB0 + 2 * VIMG;
    if (wid < 4) {
        for (int t = 0; t <= NT; ++t) {
            if (t + 1 < NT) ATT_GLOAD(t + 1);
            if (t <= my_last) {
                const bool diag = (t == my_last);
                ATT_RQKS(t, 0, ko); ATT_RPV(vo);
                if (!(diag && !(q0w & 32))) { ATT_RQKS(t, 1, ko); ATT_RPV(vo + 2048); }
            }
            if (t + 1 < NT) ATT_LWRITE(KIMG - ko, vn);
            __syncthreads();
            ko = KIMG - ko; { const int tmp = vp; vp = vo; vo = vn; vn = tmp; }
        }
    } else {
        int pva = VB0;
        for (int t = 0; t <= NT; ++t) {
            if (t + 1 < NT) ATT_GLOAD(t + 1);
            if (t <= my_last + 1) {
                const bool diag = (t == my_last);
                ATT_RPV(pva);
                if (t <= my_last) {
                    ATT_RQKS(t, 0, ko);
                    if (!(diag && !(q0w & 32))) { ATT_RPV(vo); ATT_RQKS(t, 1, ko); pva = vo + 2048; } else pva = vo;
                }
            }
            if (t + 1 < NT) ATT_LWRITE(KIMG - ko, vn);
            __syncthreads();
            ko = KIMG - ko; { const int tmp = vp; vp = vo; vo = vn; vn = tmp; }
        }
    }
#undef ATT_GLOAD
#undef ATT_LWRITE
#undef ATT_RQKS
#undef ATT_RPV
    const size_t orow = rowbase + q0w + r;
#define ATT_SWAP(a_, b_) __builtin_amdgcn_permlane32_swap((a_), (b_), false, false)
    {
        float ss = 0.f;
#pragma unroll
        for (int k = 0; k < 4; ++k)
#pragma unroll
            for (int i = 0; i < 16; ++i) ss += O[k][i] * O[k][i];
        ss = xhalf_sum(ss);
        const float rn = rsqrtf(ss * (1.0f / 128.0f) + 1e-6f);
        const bf16_t* gp_ = proj + orow * PP + 2560 + h * 128 + 8 * hh;
        bf16_t* op = mix + orow * MIXP + 512 + h * 128 + 8 * hh;
#pragma unroll
        for (int k = 0; k < 4; ++k)
#pragma unroll
            for (int gp = 0; gp < 4; gp += 2) {
                const u32x4 L = *(const u32x4*)(gp_ + 32 * k + 8 * gp);
                const auto t1 = ATT_SWAP(L.x, L.z), t2 = ATT_SWAP(L.y, L.w);
                u32x2 wg[2];
#pragma unroll
                for (int e = 0; e < 2; ++e) { const int g = gp + e; const unsigned gx = t1[e], gy = t2[e];
                    float gt[4] = {__uint_as_float(gx << 16), __uint_as_float(gx & 0xffff0000u), __uint_as_float(gy << 16), __uint_as_float(gy & 0xffff0000u)};
                    float ov[4];
#pragma unroll
                    for (int j = 0; j < 4; ++j) { const float sg = gt[j] * __builtin_amdgcn_rcpf(1.0f + __builtin_amdgcn_exp2f(-gt[j] * LOG2E)); ov[j] = O[k][4 * g + j] * rn * sg; }
                    wg[e].x = cvtpk(ov[0], ov[1]); wg[e].y = cvtpk(ov[2], ov[3]); }
                const auto s1 = ATT_SWAP(wg[0].x, wg[1].x), s2 = ATT_SWAP(wg[0].y, wg[1].y);
                u32x4 o; o.x = s1[0]; o.y = s2[0]; o.z = s1[1]; o.w = s2[1];
                *(u32x4*)(op + 32 * k + 8 * gp) = o;
            }
    }
#undef ATT_SWAP
}
}


#ifndef MK_MULTI_LAUNCH
#define MK_MULTI_LAUNCH 0
#endif
#define LAS __attribute__((address_space(3)))
typedef unsigned short bf16;
typedef float f32x4 __attribute__((ext_vector_type(4)));
typedef unsigned v4u __attribute__((ext_vector_type(4)));
typedef unsigned v2u __attribute__((ext_vector_type(2)));

#define XB_TMO      128
#define XB_XCNT(j)  (256  + 64 * (j))
#define XB_XSUB(j)  (1280 + 64 * (j))
#define XB_XGEN(j)  (2304 + 64 * (j))
#define XB_TOP      3328
#define XB_TOPGEN   3392
#define XCD_BAR_WORDS 3456
#define XB_SPIN_CAP (1u << 18)

__device__ __forceinline__ unsigned xb_ld(unsigned* p)              { return __hip_atomic_load(p, __ATOMIC_RELAXED, __HIP_MEMORY_SCOPE_AGENT); }
__device__ __forceinline__ unsigned xb_add(unsigned* p, unsigned v) { return __hip_atomic_fetch_add(p, v, __ATOMIC_RELAXED, __HIP_MEMORY_SCOPE_AGENT); }
__device__ __forceinline__ unsigned xb_xcc_id() { return (unsigned)__builtin_amdgcn_s_getreg((3 << 11) | 20) & 0xFu; }
#define XB_SPIN(cond, bar) do { unsigned _sp = 0; while (cond) { __builtin_amdgcn_s_sleep(1); \
    if ((++_sp & 255u) == 0u) { if (xb_ld(&(bar)[XB_TMO])) break; if (_sp > XB_SPIN_CAP) { atomicAdd(&(bar)[XB_TMO], 1u); break; } } } } while (0)

struct XcdBarrier {
    unsigned* bar; unsigned x;
    volatile LAS unsigned* st;
};

__device__ __forceinline__ XcdBarrier xcd_barrier_post(unsigned* bar, volatile LAS unsigned* st) {
    XcdBarrier b; b.bar = bar; b.x = xb_xcc_id(); b.st = st;
    if (threadIdx.x == 0) (void)xb_add(&bar[XB_XCNT(b.x)], 1u);
    return b;
}
__device__ __forceinline__ void xcd_barrier_complete(unsigned* bar, unsigned x, unsigned& nloc, unsigned& nx) {
    const unsigned G = gridDim.x * gridDim.y * gridDim.z;
    unsigned sum, cnt, mine, sp = 0u;
    for (;;) {
        sum = 0u; cnt = 0u; mine = 0u;
#pragma unroll
        for (unsigned j = 0; j < 16; ++j) { const unsigned c = xb_ld(&bar[XB_XCNT(j)]); sum += c; cnt += (c > 0u) ? 1u : 0u; mine = (j == x) ? c : mine; }
        if (sum == G) break;
        __builtin_amdgcn_s_sleep(1);
        if ((++sp & 255u) == 0u) { if (xb_ld(&bar[XB_TMO])) break; if (sp > XB_SPIN_CAP) { atomicAdd(&bar[XB_TMO], 1u); break; } }
    }
    nloc = mine > 0u ? mine : 1u; nx = cnt > 0u ? cnt : 1u;
}

__device__ __forceinline__ void xcd_barrier(const XcdBarrier& b) {
    asm volatile("s_waitcnt vmcnt(0)" ::: "memory");
    __syncthreads();
    if (threadIdx.x == 0) {
        unsigned* bar = b.bar;
        __builtin_amdgcn_s_waitcnt(0);
        unsigned nloc = b.st[0], nx = b.st[1];
        if (nloc == 0u) { xcd_barrier_complete(bar, b.x, nloc, nx); b.st[0] = nloc; b.st[1] = nx; }
        const unsigned old = xb_add(&bar[XB_XSUB(b.x)], 1u);
        const unsigned gen = old / nloc;
        if (old + 1u == (gen + 1u) * nloc) {
            __builtin_amdgcn_fence(__ATOMIC_RELEASE, "agent");
            asm volatile("s_waitcnt vmcnt(0)" ::: "memory");
            const unsigned og = xb_add(&bar[XB_TOP], 1u);
            const unsigned tg = og / nx;
            if (og + 1u == (tg + 1u) * nx) xb_add(&bar[XB_TOPGEN], 1u);
            else XB_SPIN(xb_ld(&bar[XB_TOPGEN]) == tg, bar);
            __builtin_amdgcn_fence(__ATOMIC_ACQUIRE, "agent");
            xb_add(&bar[XB_XGEN(b.x)], 1u);
            asm volatile("s_waitcnt vmcnt(0)" ::: "memory");
        } else {
            XB_SPIN(xb_ld(&bar[XB_XGEN(b.x)]) == gen, bar);
            __builtin_amdgcn_fence(__ATOMIC_ACQUIRE, "agent");
            asm volatile("s_waitcnt vmcnt(0)" ::: "memory");
        }
    }
    __syncthreads();
}

constexpr int BATCH = 16, SEQ = 2048, D = 1024, DEPTH = 2, FF = 2816, INC = 3072;
constexpr int M = BATCH * SEQ;
constexpr int NPH = 2 + 7 * DEPTH;
constexpr size_t MiB = 1u << 20;
constexpr size_t WS_RSS = 0;
constexpr size_t WS_WFF = 2 * MiB, WFF_SZ = (size_t)2 * FF * D * 2;
constexpr size_t WS_WDN = WS_WFF + 4 * WFF_SZ, WDN_SZ = (size_t)D * FF * 2;
constexpr size_t WS_WIN = WS_WDN + 4 * WDN_SZ, WIN_SZ = (size_t)INC * D * 2;
constexpr size_t WS_WOUT = WS_WIN + 2 * WIN_SZ, WOUT_SZ = (size_t)D * D * 2;
constexpr size_t WS_XB = WS_WOUT + 2 * WOUT_SZ;
constexpr size_t WS_MIX = WS_XB + (size_t)M * D * 2;
constexpr size_t WS_HP = WS_MIX + (size_t)M * D * 2;
constexpr size_t WS_END = WS_HP + (size_t)M * INC * 2;
constexpr size_t WS_CTL = WS_END, CTL_BYTES = 16384;
static_assert(WS_CTL + CTL_BYTES <= 512 * MiB && XCD_BAR_WORDS * 4 <= CTL_BYTES, "d_ws map");
constexpr int LDS_BYTES = 136 * 1024;

struct Args { const float* in[18]; float* out; unsigned char* ws; int ph_lo, ph_hi; };

__device__ __forceinline__ unsigned f2bf(float f) { unsigned u = __builtin_bit_cast(unsigned, f); return (u + 0x7fffu + ((u >> 16) & 1u)) >> 16; }
__device__ __forceinline__ unsigned pk2(float lo, float hi) { return f2bf(lo) | (f2bf(hi) << 16); }
__device__ __forceinline__ float wave_sum(float v) {
    v += __int_as_float(__builtin_amdgcn_ds_swizzle(__float_as_int(v), (1 << 10) | 0x1f));
    v += __int_as_float(__builtin_amdgcn_ds_swizzle(__float_as_int(v), (2 << 10) | 0x1f));
    v += __int_as_float(__builtin_amdgcn_ds_swizzle(__float_as_int(v), (4 << 10) | 0x1f));
    v += __int_as_float(__builtin_amdgcn_ds_swizzle(__float_as_int(v), (8 << 10) | 0x1f));
    return pg8::x32_sum(pg8::x16_sum(v));
}
__device__ __forceinline__ void tr_item(const float* __restrict__ W, int K, int N, bf16* __restrict__ WT, const float* __restrict__ gain, float cs, int k0, int n0, int drow0, LAS float* scr, int lane) {
    const int c4 = lane & 7, kr = lane >> 3;
    f32x4 v[8]; float g[8];
#pragma unroll
    for (int i = 0; i < 8; ++i) { const int kk = 8 * i + kr; v[i] = *(const f32x4*)(W + (size_t)(k0 + kk) * N + n0 + 4 * c4); g[i] = gain ? gain[k0 + kk] * cs : cs; }
#pragma unroll
    for (int i = 0; i < 8; ++i) { const int kk = 8 * i + kr; LAS float* d = scr + kk * 33 + 4 * c4;
        d[0] = v[i][0] * g[i]; d[1] = v[i][1] * g[i]; d[2] = v[i][2] * g[i]; d[3] = v[i][3] * g[i]; }
    asm volatile("s_waitcnt lgkmcnt(0)" ::: "memory");
    const int c = lane & 7;
#pragma unroll
    for (int j = 0; j < 4; ++j) { const int n = (lane >> 3) + 8 * j; const LAS float* s = scr + (8 * c) * 33 + n;
        v4u o; o.x = pk2(s[0 * 33], s[1 * 33]); o.y = pk2(s[2 * 33], s[3 * 33]); o.z = pk2(s[4 * 33], s[5 * 33]); o.w = pk2(s[6 * 33], s[7 * 33]);
        const int rho = ((n >> 2) & 1) * 16 + ((n >> 3) << 2) + (n & 3);
        *(v4u*)(WT + (size_t)(drow0 + rho) * K + k0 + 8 * c) = o; }
    asm volatile("s_waitcnt lgkmcnt(0)" ::: "memory");
}

__global__ void __launch_bounds__(512, 2) mega_fwd(Args args) {
    extern __shared__ __attribute__((aligned(16))) unsigned char lds_raw[];
    LAS unsigned char* lds = (LAS unsigned char*)lds_raw;
    cg::grid_group grid = cg::this_grid();
    const int G = gridDim.x, bx = blockIdx.x;
    const int vcu = (G % 8 == 0) ? (bx % 8) * (G / 8) + bx / 8 : bx;
    unsigned char* ws = args.ws;
    float* RSS = (float*)(ws + WS_RSS);
    bf16* XB = (bf16*)(ws + WS_XB); bf16* MIX = (bf16*)(ws + WS_MIX); bf16* HP = (bf16*)(ws + WS_HP);
    float* X = args.out;
    const int lo = args.ph_lo, hi = args.ph_hi;
    volatile LAS unsigned* bst = (volatile LAS unsigned*)(lds + LDS_BYTES - 64);
    if (threadIdx.x < 2) bst[threadIdx.x] = 0u;
    __syncthreads();
    XcdBarrier bar = xcd_barrier_post((unsigned*)(ws + WS_CTL), bst);
#define IN(k) (lo <= (k) && (k) < hi)

#ifndef PROF_P
#define PROF_P -1
#endif
#ifndef PROBE_KINDS
#define PROBE_KINDS 0u
#endif
    constexpr int PMUL = PROBE_KINDS ? 2 : 1;
#pragma unroll 1
    for (int pp = lo * PMUL; pp < hi * PMUL; ++pp) {
    const int p = pp / PMUL;
    const int pk = (p == 0) ? 7 : (p == NPH - 1) ? 8 : (p - 1) % 7;
    const int l = (p - 1) / 7;
    if (PMUL > 1 && (pp % PMUL) && !((PROBE_KINDS >> pk) & 1u)) continue;
    int tid_ = threadIdx.x; asm volatile("" : "+v"(tid_));
    const int tid = tid_, lane = tid & 63, wave = __builtin_amdgcn_readfirstlane(tid >> 6); (void)tid;
    if (pk == 7) {
        LAS float* scr = (LAS float*)(lds + wave * 16384);
        const int gw = vcu * 8 + wave, NGW = G * 8;
        constexpr int PER_LAYER = 6 * 1408 + 1536 + 512, TOTAL = DEPTH * PER_LAYER;
        for (int g = gw; g < TOTAL; g += NGW) {
            const int ll = g / PER_LAYER; int r = g % PER_LAYER;
            if (r < 4 * 1408) {
                const int m = r / 1408, it = r % 1408, f = m >> 1, up = m & 1;
                const float* W = args.in[f == 0 ? (up ? 3 : 2) : (up ? 15 : 14)] + (size_t)ll * D * FF;
                const float* gain = args.in[f == 0 ? 1 : 13] + ll * D;
                bf16* WT = (bf16*)(ws + WS_WFF + (size_t)(ll * 2 + f) * WFF_SZ);
                const int kb = it / 88, nb = it % 88, n0 = nb * 32;
                tr_item(W, D, FF, WT, gain, 1.0f, kb * 64, n0, 256 * (n0 >> 7) + 128 * up + (n0 & 127), scr, lane);
            } else if (r < 6 * 1408) {
                const int m = r / 1408 - 4, it = r % 1408;
                const float* W = args.in[m == 0 ? 4 : 16] + (size_t)ll * FF * D;
                bf16* WT = (bf16*)(ws + WS_WDN + (size_t)(ll * 2 + m) * WDN_SZ);
                const int kb = it / 32, nb = it % 32;
                tr_item(W, FF, D, WT, nullptr, 1.0f, kb * 64, nb * 32, nb * 32, scr, lane);
            } else if (r < 6 * 1408 + 1536) {
                const int it = r - 6 * 1408, kb = it / 96, nb = it % 96, n0 = nb * 32;
                const float cs = (n0 < 512) ? 0.125f * 1.4426950408889634f : ((n0 >= 1792 && n0 < 2048) ? 0.125f : 1.0f);
                tr_item(args.in[6] + (size_t)ll * D * INC, D, INC, (bf16*)(ws + WS_WIN + (size_t)ll * WIN_SZ), args.in[5] + ll * D, cs, kb * 64, n0, n0, scr, lane);
            } else {
                const int it = r - 6 * 1408 - 1536, kb = it / 32, nb = it % 32;
                tr_item(args.in[12] + (size_t)ll * D * D, D, D, (bf16*)(ws + WS_WOUT + (size_t)ll * WOUT_SZ), nullptr, 1.0f, kb * 64, nb * 32, nb * 32, scr, lane);
            }
        }
        const float* x = args.in[0];
        for (int m = gw; m < M; m += 2 * NGW) {
            const int m2 = m + NGW;
            const f32x4* xr0 = (const f32x4*)(x + (size_t)m * D) + lane; const f32x4* xr1 = (const f32x4*)(x + (size_t)(m2 < M ? m2 : m) * D) + lane;
            f32x4 v0[4], v1[4];
#pragma unroll
            for (int j = 0; j < 4; ++j) { v0[j] = xr0[64 * j]; v1[j] = xr1[64 * j]; }
            float s0 = 0.f, s1 = 0.f;
            v2u* o0 = (v2u*)(XB + (size_t)m * D) + lane; v2u* o1 = (v2u*)(XB + (size_t)(m2 < M ? m2 : m) * D) + lane;
#pragma unroll
            for (int j = 0; j < 4; ++j) {
                s0 += (v0[j][0] * v0[j][0] + v0[j][1] * v0[j][1]) + (v0[j][2] * v0[j][2] + v0[j][3] * v0[j][3]);
                s1 += (v1[j][0] * v1[j][0] + v1[j][1] * v1[j][1]) + (v1[j][2] * v1[j][2] + v1[j][3] * v1[j][3]);
                v2u w; w.x = pk2(v0[j][0], v0[j][1]); w.y = pk2(v0[j][2], v0[j][3]); o0[64 * j] = w;
                if (m2 < M) { v2u w1; w1.x = pk2(v1[j][0], v1[j][1]); w1.y = pk2(v1[j][2], v1[j][3]); o1[64 * j] = w1; } }
            s0 = wave_sum(s0); s1 = wave_sum(s1);
            if (lane < 16) { RSS[(size_t)m * 16 + lane] = lane == 0 ? s0 : 0.f; if (m2 < M) RSS[(size_t)m2 * 16 + lane] = lane == 0 ? s1 : 0.f; }
        }
    } else if (pk == 0 || pk == 5) {
        const int f = pk == 5;
        pg8::Gemm g{XB, (const bf16*)(ws + WS_WFF + (size_t)(l * 2 + f) * WFF_SZ), M, 2 * FF, D}; pg8::StaticOrder S; S.init(M, 2 * FF, G, bx);
        pg8::EpiSwiglu E{HP, FF, RSS, {0.f, 0.f, 0.f, 0.f, 0.f, 0.f, 0.f, 0.f}, -1};
        if (PROF_P >= 0 && p == PROF_P) pg8::gemm_phase<pg8::EpiSwiglu, pg8::StaticOrder, true, true, true>(lds, g, S, E, (unsigned long long*)(ws + WS_CTL + 15360));
        else pg8::gemm_phase<pg8::EpiSwiglu, pg8::StaticOrder, true, true>(lds, g, S, E);
    } else if (pk == 2) {
        pg8::Gemm g{XB, (const bf16*)(ws + WS_WIN + (size_t)l * WIN_SZ), M, INC, D}; pg8::StaticOrder S; S.init(M, INC, G, bx);
        pg8::EpiProj E{HP, INC, RSS, {0.f, 0.f, 0.f, 0.f, 0.f, 0.f, 0.f, 0.f}, -1};
        pg8::gemm_phase<pg8::EpiProj, pg8::StaticOrder, true, true>(lds, g, S, E);
    } else if (pk == 3) {
        const float lam_init = 0.8f - 0.6f * expf(-0.3f * (float)l);
        float s1 = args.in[7][l * 64 + lane] * args.in[8][l * 64 + lane], s2 = args.in[9][l * 64 + lane] * args.in[10][l * 64 + lane];
        s1 = wave_sum(s1); s2 = wave_sum(s2);
        const float lam = expf(s1) - expf(s2) + lam_init;
        const float* subln = args.in[11] + l * 128;
        for (int v = vcu; v < 256; v += G) {
            const int bh = v >> 2, s = v & 3, b = bh >> 2, h = bh & 3;
#pragma unroll 1
            for (int i = 0; i < 2; ++i) att::unit<false>(lds, HP, MIX, b, h, i == 0 ? 7 - s : s, lam, 1.0f - lam_init, subln);
#pragma unroll 1
            for (int i = 0; i < 2; ++i) att::unit_rets(lds, HP, MIX, b, h, i == 0 ? 7 - s : s);
        }
    } else if (pk == 8) {
        const int gw = vcu * 8 + wave, NGW = G * 8;
        const float* gf = args.in[17];
        for (int m = gw; m < M; m += NGW) {
            float s = lane < 16 ? RSS[(size_t)m * 16 + lane] : 0.f; s = wave_sum(s);
            const float rstd = rsqrtf(s * (1.0f / D) + 1e-6f);
            const v2u* xb = (const v2u*)(XB + (size_t)m * D) + lane;
            f32x4* xr = (f32x4*)(X + (size_t)m * D) + lane;
#pragma unroll
            for (int j = 0; j < 4; ++j) { const v2u w = xb[64 * j]; const f32x4 gv = ((const f32x4*)gf)[lane + 64 * j];
                f32x4 v; v[0] = __uint_as_float(w.x << 16); v[1] = __uint_as_float(w.x & 0xffff0000u); v[2] = __uint_as_float(w.y << 16); v[3] = __uint_as_float(w.y & 0xffff0000u);
                xr[64 * j] = v * rstd * gv; }
        }
        if (PROF_P >= 0) { __syncthreads(); if (bx == 0 && tid == 0) { const unsigned long long* pr = (const unsigned long long*)(ws + WS_CTL + 15360); asm volatile("s_waitcnt vmcnt(0)" ::: "memory"); X[0] = 100.0f * (float)pr[0] / (float)pr[1]; } }
    } else {
        const bool outp = pk == 4; const int f = pk == 6;
        const bf16* A = outp ? MIX : HP;
        const bf16* Bt = outp ? (const bf16*)(ws + WS_WOUT + (size_t)l * WOUT_SZ) : (const bf16*)(ws + WS_WDN + (size_t)(l * 2 + f) * WDN_SZ);
        pg8::Gemm g{A, Bt, M, D, outp ? D : FF}; pg8::StaticOrder S; S.init(M, D, G, bx);
        pg8::EpiResid E{XB, RSS, outp ? 1.0f : 0.5f};
        if (PROF_P >= 0 && p == PROF_P) pg8::gemm_phase<pg8::EpiResid, pg8::StaticOrder, true, true, true>(lds, g, S, E, (unsigned long long*)(ws + WS_CTL + 15360));
        else pg8::gemm_phase<pg8::EpiResid, pg8::StaticOrder, true, true>(lds, g, S, E);
    }
    if (pp + 1 < hi * PMUL) { if (lo < 0) grid.sync(); else xcd_barrier(bar); }
    }
#undef IN
}

extern "C" void kernel_launch(void* const* d_in, const int* in_sizes, int n_in, void* d_out, int out_size, void* d_ws, size_t ws_size, hipStream_t stream) {
    static int grid = 0;
    if (grid == 0) {
        if (n_in != 18 || out_size != M * D || ws_size < WS_CTL + CTL_BYTES) { fprintf(stderr, "kernel_launch: unexpected shapes (n_in %d out %d ws %zu)\n", n_in, out_size, ws_size); grid = -1; return; }
        int dev = 0, cus = 0, per_cu = 0;
        (void)hipGetDevice(&dev); (void)hipDeviceGetAttribute(&cus, hipDeviceAttributeMultiprocessorCount, dev);
        if (hipFuncSetAttribute((const void*)mega_fwd, hipFuncAttributeMaxDynamicSharedMemorySize, LDS_BYTES) != hipSuccess) { fprintf(stderr, "kernel_launch: hipFuncSetAttribute failed\n"); grid = -1; return; }
        if (hipOccupancyMaxActiveBlocksPerMultiprocessor(&per_cu, (const void*)mega_fwd, 512, LDS_BYTES) != hipSuccess || per_cu < 1) { fprintf(stderr, "kernel_launch: occupancy query says %d\n", per_cu); per_cu = 1; }
        (void)hipGetLastError();
        grid = cus * 1;
        if (grid <= 0) grid = 256;
    }
    if (grid < 0) return;
    (void)hipMemsetAsync((unsigned char*)d_ws + WS_CTL, 0, CTL_BYTES, stream);
    Args a{};
    for (int i = 0; i < 18; ++i) a.in[i] = (const float*)d_in[i];
    a.out = (float*)d_out; a.ws = (unsigned char*)d_ws;
#if MK_MULTI_LAUNCH
    for (int p = 0; p < NPH; ++p) { a.ph_lo = p; a.ph_hi = p + 1; hipLaunchKernelGGL(mega_fwd, dim3(grid), dim3(512), LDS_BYTES, stream, a); }
#else
    a.ph_lo = 0; a.ph_hi = NPH;
    void* kargs[] = {&a};
    hipError_t e = hipLaunchCooperativeKernel((const void*)mega_fwd, dim3(grid), dim3(512), kargs, LDS_BYTES, stream);
    if (e != hipSuccess) fprintf(stderr, "cooperative launch failed: %s (grid %d)\n", hipGetErrorString(e), grid);
#endif
}
```

```cpp
#include <hip/hip_runtime.h>
#include <hip/hip_cooperative_groups.h>
#include <cstdio>
#include <cstdint>
namespace cg = cooperative_groups;
namespace pg8 {
#define PG8_LAS __attribute__((address_space(3)))
typedef unsigned short bf16_t;
typedef short bf16x8 __attribute__((ext_vector_type(8)));
typedef float f32x4 __attribute__((ext_vector_type(4)));
typedef unsigned u32x4 __attribute__((ext_vector_type(4)));
constexpr int BM = 256, BK = 64, HALF = 128, HTB = HALF * BK * 2  , STAGE_BYTES = 8 * HTB, NXCD = 8, WGM = 8;

__host__ __device__ __forceinline__ int lds_byte(int r, int c) { const int st = (r >> 4) * 2 + (c >> 5), rr = r & 15, cc = c & 31, ob = rr * 64 + cc * 2; return st * 1024 + (ob ^ (((ob >> 9) & 1) << 5)); }
__host__ __device__ __forceinline__ void stage_rc(int b, int& R, int& C) { const int st = b / 1024, sb = b % 1024, swz = sb ^ (((sb >> 9) & 1) << 5); R = (st >> 1) * 16 + swz / 64; C = (st & 1) * 32 + (swz % 64) / 2; }
__host__ __device__ __forceinline__ int perm32(int rho) { const int n = rho >> 4, i = rho & 15; return 8 * (i >> 2) + 4 * n + (i & 3); }

struct Unit { int pm, pn; };
struct Gemm { const bf16_t* A; const bf16_t* Bt; int M, N, K; };

struct StaticOrder {
    int nM, nN, nwg, G, c;
    __host__ __device__ void init(int M, int N, int G_, int c_) { nM = M / BM; nN = N / BM; nwg = nM * nN; G = G_; c = c_; }
    __host__ __device__ bool next(int i, Unit& u) const {
        const long L = (long)i * G + c; if (L >= nwg) return false;
        int wgid = (int)L; { const int q = nwg / NXCD, r = nwg % NXCD, xcd = wgid % NXCD, off = wgid / NXCD; wgid = (xcd < r ? xcd * (q + 1) : r * (q + 1) + (xcd - r) * q) + off; }
        const int nig = WGM * nN, gid = wgid / nig, fm = gid * WGM, gsz = (nM - fm) < WGM ? (nM - fm) : WGM;
        u.pm = fm + ((wgid % nig) % gsz); u.pn = (wgid % nig) / gsz; return true;
    }
    __device__ __forceinline__ void a_ready(const Unit&) const {}
    __device__ __forceinline__ void done(const Unit&) const {}
};

typedef unsigned u32x2 __attribute__((ext_vector_type(2)));
#ifndef PEEL_SWI
#define PEEL_SWI true
#endif
#ifndef PEEL_PROJ
#define PEEL_PROJ false
#endif
#ifndef PEEL_RES
#define PEEL_RES false
#endif
__device__ __forceinline__ unsigned cvt_pk_bf16(float lo, float hi) { unsigned r; asm volatile("v_cvt_pk_bf16_f32 %0, %1, %2" : "=v"(r) : "v"(lo), "v"(hi)); return r; }
__device__ __forceinline__ float x16_sum(float v) { auto rr = __builtin_amdgcn_permlane16_swap(__float_as_uint(v), __float_as_uint(v), false, false); return __uint_as_float(rr[0]) + __uint_as_float(rr[1]); }
__device__ __forceinline__ float x32_sum(float v) { auto rr = __builtin_amdgcn_permlane32_swap(__float_as_uint(v), __float_as_uint(v), false, false); return __uint_as_float(rr[0]) + __uint_as_float(rr[1]); }
constexpr float RMS_EPS = 1e-6f;
__device__ __forceinline__ float row_rstd(const float* rss, int row, int fq) {
    const f32x4 v = *(const f32x4*)(rss + (size_t)row * 16 + 4 * fq);
    float s = (v[0] + v[1]) + (v[2] + v[3]);
    s = x32_sum(x16_sum(s));
    return rsqrtf(s * (1.0f / 1024.0f) + RMS_EPS);
}
__device__ __forceinline__ float silu_mul(float g, float u) {
    const float e = __builtin_amdgcn_exp2f(g * -1.4426950408889634f);
    return g * __builtin_amdgcn_rcpf(1.0f + e) * u;
}
__device__ __forceinline__ void row_rstd8(const float* rss, int row0, int fq, float (&r)[8]) {
    f32x4 v[8];
#pragma unroll
    for (int j = 0; j < 8; ++j) v[j] = *(const f32x4*)(rss + (size_t)(row0 + (j >> 2) * HALF + (j & 3) * 16) * 16 + 4 * fq);
#pragma unroll
    for (int j = 0; j < 8; ++j) { float s = (v[j][0] + v[j][1]) + (v[j][2] + v[j][3]); s = x32_sum(x16_sum(s)); r[j] = rsqrtf(s * (1.0f / 1024.0f) + RMS_EPS); }
}
struct EpiSwiglu {
    static constexpr bool PERM = true, AFTER_DRAIN = false; static constexpr int NVM = 8; static constexpr bool PEEL = PEEL_SWI, PRE_PERMUTED = true;
    bf16_t* H; int ldh; const float* rss; mutable float rs[8]; mutable int cpm;
    __device__ __forceinline__ void operator()(const f32x4 (&acc)[2][2][4][2], const Unit& u, int wr, int wc, int fr, int fq) const {
        const int row0 = u.pm * BM + wr * 64 + fr, col0 = u.pn * HALF + wc * 32 + 8 * fq;
        if (u.pm != cpm) { row_rstd8(rss, row0, fq, rs); cpm = u.pm; }
#pragma unroll
        for (int ai = 0; ai < 2; ++ai)
#pragma unroll
            for (int m = 0; m < 4; ++m) {
                const int row = row0 + ai * HALF + m * 16;
                const float r = rs[ai * 4 + m];
                const f32x4 g0 = acc[ai][0][m][0] * r, g1 = acc[ai][0][m][1] * r, u0 = acc[ai][1][m][0] * r, u1 = acc[ai][1][m][1] * r;
                u32x4 w;
                w.x = cvt_pk_bf16(silu_mul(g0[0], u0[0]), silu_mul(g0[1], u0[1])); w.y = cvt_pk_bf16(silu_mul(g0[2], u0[2]), silu_mul(g0[3], u0[3]));
                w.z = cvt_pk_bf16(silu_mul(g1[0], u1[0]), silu_mul(g1[1], u1[1])); w.w = cvt_pk_bf16(silu_mul(g1[2], u1[2]), silu_mul(g1[3], u1[3]));
                *(u32x4*)(H + (size_t)row * ldh + col0) = w;
            }
    }
};
struct EpiProj {
    static constexpr bool PERM = true, AFTER_DRAIN = false; static constexpr int NVM = 16; static constexpr bool PEEL = PEEL_PROJ, PRE_PERMUTED = true;
    bf16_t* O; int ldc; const float* rss; mutable float rs[8]; mutable int cpm;
    __device__ __forceinline__ void operator()(const f32x4 (&acc)[2][2][4][2], const Unit& u, int wr, int wc, int fr, int fq) const {
        const int row0 = u.pm * BM + wr * 64 + fr, col0 = u.pn * BM + wc * 32 + 8 * fq;
        if (u.pm != cpm) { row_rstd8(rss, row0, fq, rs); cpm = u.pm; }
#pragma unroll
        for (int ai = 0; ai < 2; ++ai)
#pragma unroll
            for (int m = 0; m < 4; ++m) {
                const int row = row0 + ai * HALF + m * 16;
                const float r = rs[ai * 4 + m];
                bf16_t* rowp = O + (size_t)row * ldc + col0;
#pragma unroll
                for (int bj = 0; bj < 2; ++bj) {
                    const float rk = (u.pn == 7) ? r * __builtin_amdgcn_exp2f(-__builtin_log2f(1.0f - __builtin_amdgcn_exp2f(-5.0f - (float)(2 * bj + (wc >> 1)))) * (float)(row & 31)) : r;
                    const f32x4 v0 = acc[ai][bj][m][0] * rk, v1 = acc[ai][bj][m][1] * rk;
                    u32x4 w; w.x = cvt_pk_bf16(v0[0], v0[1]); w.y = cvt_pk_bf16(v0[2], v0[3]); w.z = cvt_pk_bf16(v1[0], v1[1]); w.w = cvt_pk_bf16(v1[2], v1[3]);
                    *(u32x4*)(rowp + bj * HALF) = w; }
            }
    }
};
struct EpiResid {
    static constexpr bool PERM = true, AFTER_DRAIN = false; static constexpr int NVM = 16; static constexpr bool PEEL = PEEL_RES, PRE_PERMUTED = true;
    bf16_t* XB; float* rss; float alpha;
    __device__ __forceinline__ void operator()(const f32x4 (&acc)[2][2][4][2], const Unit& u, int wr, int wc, int fr, int fq) const {
        const int row0 = u.pm * BM + wr * 64 + fr, col0 = u.pn * BM + wc * 32 + 8 * fq;
        u32x4 rv[2][2];
#define EPR_LOAD(buf, g) do { const size_t off_ = (size_t)(row0 + ((g) >> 2) * HALF + ((g) & 3) * 16) * 1024 + col0; \
        rv[buf][0] = *(const u32x4*)(XB + off_); rv[buf][1] = *(const u32x4*)(XB + off_ + HALF); } while (0)
        EPR_LOAD(0, 0);
#pragma unroll
        for (int g = 0; g < 8; ++g) {
            const int ai = g >> 2, m = g & 3, cb = g & 1;
            if (g + 1 < 8) EPR_LOAD(cb ^ 1, g + 1);
            const int row = row0 + ai * HALF + m * 16; const size_t off = (size_t)row * 1024 + col0; float ss = 0.f;
#pragma unroll
            for (int bj = 0; bj < 2; ++bj) {
                const u32x4 w = rv[cb][bj];
                f32x4 va, vb;
                va[0] = __uint_as_float(w.x << 16); va[1] = __uint_as_float(w.x & 0xffff0000u); va[2] = __uint_as_float(w.y << 16); va[3] = __uint_as_float(w.y & 0xffff0000u);
                vb[0] = __uint_as_float(w.z << 16); vb[1] = __uint_as_float(w.z & 0xffff0000u); vb[2] = __uint_as_float(w.w << 16); vb[3] = __uint_as_float(w.w & 0xffff0000u);
                va = va + acc[ai][bj][m][0] * alpha; vb = vb + acc[ai][bj][m][1] * alpha;
                ss += (va[0] * va[0] + va[1] * va[1]) + (va[2] * va[2] + va[3] * va[3]) + (vb[0] * vb[0] + vb[1] * vb[1]) + (vb[2] * vb[2] + vb[3] * vb[3]);
                u32x4 o; o.x = cvt_pk_bf16(va[0], va[1]); o.y = cvt_pk_bf16(va[2], va[3]); o.z = cvt_pk_bf16(vb[0], vb[1]); o.w = cvt_pk_bf16(vb[2], vb[3]);
                *(u32x4*)(XB + off + bj * HALF) = o;
            }
            ss = x32_sum(x16_sum(ss));
            if (fq == 0) rss[(size_t)row * 16 + 4 * u.pn + wc] = ss;
        }
#undef EPR_LOAD
    }
};

template <class Epi, class Sched, bool ALIGN_EPI = false, bool SP2 = false, bool PROF = false>
__device__ __forceinline__ void gemm_phase(PG8_LAS unsigned char* lds, const Gemm g, const Sched& S, const Epi& E, unsigned long long* prof = nullptr) {
    unsigned long long pf_t0 = 0, pf_kl = 0, pf_ks = 0; if constexpr (PROF) pf_t0 = __builtin_readcyclecounter();
    int tid_ = threadIdx.x; asm volatile("" : "+v"(tid_));
    const int tid = tid_, wid = __builtin_amdgcn_readfirstlane(tid >> 6), lane = tid & 63, wr = wid >> 2, wc = wid & 3, fr = lane & 15, fq = lane >> 4;
    const int K = g.K, nt = K / BK;
    unsigned voffA, voffB;
    { int R, C; stage_rc(tid * 16, R, C); const int Rb = (Epi::PERM && !Epi::PRE_PERMUTED) ? ((R & ~31) + perm32(R & 31)) : R;
        voffA = (unsigned)(R * K + C) * 2u; voffB = (unsigned)(Rb * K + C) * 2u; }
    const size_t qstep = (size_t)64 * K * 2;
    const size_t kstep = (size_t)(BK * 2);
    const size_t hstep = (size_t)HALF * K * 2;
    const size_t tstep = 2 * hstep;
    const unsigned ldsw = (unsigned)wid * 1024u;
    const int aoff = lds_byte(wr * 64 + fr, fq * 8), boff = lds_byte(wc * 32 + fr, fq * 8);
#define PG8_SA(b, h) (((b) * 2 + (h)) * HTB)
#define PG8_SB(b, h) ((4 + (b) * 2 + (h)) * HTB)
#define PG8_STAGE(bufoff, gbase, voff) do { _Pragma("unroll") for (int _i = 0; _i < 2; ++_i) \
        __builtin_amdgcn_global_load_lds((const unsigned*)((const char*)(gbase) + (size_t)_i * qstep + (voff)), (PG8_LAS unsigned*)(lds + (bufoff) + ldsw + _i * 8192), 16, 0, 0); } while (0)
#define PG8_LDA(dst, b, h) do { _Pragma("unroll") for (int m = 0; m < 4; ++m) _Pragma("unroll") for (int k = 0; k < 2; ++k) dst[m][k] = *(const PG8_LAS bf16x8*)(lds + PG8_SA(b, h) + aoff + m * 2048 + k * 1024); } while (0)
#define PG8_LDB(dst, b, h) do { _Pragma("unroll") for (int n = 0; n < 2; ++n) _Pragma("unroll") for (int k = 0; k < 2; ++k) dst[n][k] = *(const PG8_LAS bf16x8*)(lds + PG8_SB(b, h) + boff + n * 2048 + k * 1024); } while (0)
#define PG8_MMA(ai, bj, At, Bt) do { __builtin_amdgcn_s_setprio(1); _Pragma("unroll") for (int m = 0; m < 4; ++m) _Pragma("unroll") for (int n = 0; n < 2; ++n) _Pragma("unroll") for (int k = 0; k < 2; ++k) \
        acc[ai][bj][m][n] = __builtin_amdgcn_mfma_f32_16x16x32_bf16(Bt[n][k], At[m][k], acc[ai][bj][m][n], 0, 0, 0); __builtin_amdgcn_s_setprio(0); } while (0)
#define PG8_WAIT_V(n) asm volatile("s_waitcnt vmcnt(" #n ")" ::: "memory")
#define PG8_WAIT_L(n) asm volatile("s_waitcnt lgkmcnt(" #n ")" ::: "memory")
#define PG8_BAR __builtin_amdgcn_s_barrier()
#define PG8_WAIT_VE() do { if constexpr (Epi::NVM >= 16) PG8_WAIT_V(24); else PG8_WAIT_V(16); } while (0)
#define PG8_SCHED __builtin_amdgcn_sched_barrier(0)
    Unit cur, nxt; int ui = 0;
    if (!S.next(0, cur)) return;
    f32x4 acc[2][2][4][2];
#pragma unroll
    for (int a = 0; a < 2; ++a)
#pragma unroll
        for (int b = 0; b < 2; ++b)
#pragma unroll
            for (int m = 0; m < 4; ++m)
#pragma unroll
                for (int n = 0; n < 2; ++n) acc[a][b][m][n] = (f32x4){0.f, 0.f, 0.f, 0.f};
    bf16x8 At[4][2], B0[2][2], B1[2][2];
    const char* cA = (const char*)g.A + (size_t)cur.pm * tstep; const char* cB = (const char*)g.Bt + (size_t)cur.pn * tstep;
    S.a_ready(cur);
    if constexpr (SP2) {
        PG8_STAGE(PG8_SB(0, 0), cB, voffB); PG8_STAGE(PG8_SB(0, 1), cB + hstep, voffB); PG8_STAGE(PG8_SA(0, 0), cA, voffA); PG8_STAGE(PG8_SA(0, 1), cA + hstep, voffA);
        if (wr == 1) PG8_BAR;
        PG8_WAIT_V(2); PG8_BAR;
        PG8_STAGE(PG8_SB(1, 0), cB + kstep, voffB); PG8_STAGE(PG8_SA(1, 0), cA + kstep, voffA); PG8_STAGE(PG8_SB(1, 1), cB + hstep + kstep, voffB);
        PG8_WAIT_V(6); PG8_BAR;
    } else {
        PG8_STAGE(PG8_SB(0, 0), cB, voffB); PG8_STAGE(PG8_SA(0, 0), cA, voffA); PG8_STAGE(PG8_SB(0, 1), cB + hstep, voffB); PG8_STAGE(PG8_SA(0, 1), cA + hstep, voffA);
        if (wr == 1) PG8_BAR;
        PG8_WAIT_V(4); PG8_BAR;
        PG8_STAGE(PG8_SB(1, 0), cB + kstep, voffB); PG8_STAGE(PG8_SA(1, 0), cA + kstep, voffA); PG8_STAGE(PG8_SB(1, 1), cB + hstep + kstep, voffB);
        PG8_WAIT_V(6); PG8_BAR;
    }
    for (;;) {
        const bool has_next = S.next(ui + 1, nxt);
        const char* nA = has_next ? (const char*)g.A + (size_t)nxt.pm * tstep : cA; const char* nB = has_next ? (const char*)g.Bt + (size_t)nxt.pn * tstep : cB;
        int t = 0;
        PG8_SCHED;
        if constexpr (SP2 && ALIGN_EPI && Epi::PEEL) { if (ui > 0) {
            if constexpr (PROF) { if (t == 4) pf_ks = __builtin_readcyclecounter(); }
            const bool last = (t == nt - 2);
            const char* a1 = cA + (size_t)(t + 1) * kstep;
            const char* a2 = last ? nA : cA + (size_t)(t + 2) * kstep; const char* b2 = last ? nB : cB + (size_t)(t + 2) * kstep;
            const char* a3 = a2 + kstep; const char* b3 = b2 + kstep;
            if (last && has_next) S.a_ready(nxt);
            PG8_LDB(B0, 0, 0); PG8_LDB(B1, 0, 1); PG8_SCHED; PG8_LDA(At, 0, 0);
            PG8_WAIT_VE(); PG8_WAIT_L(0); PG8_BAR; PG8_MMA(0, 0, At, B0); PG8_MMA(0, 1, At, B1); PG8_BAR; PG8_SCHED;
            PG8_LDA(At, 0, 1); PG8_STAGE(PG8_SB(0, 0), b2, voffB); PG8_STAGE(PG8_SB(0, 1), b2 + hstep, voffB); PG8_STAGE(PG8_SA(0, 0), a2, voffA);
            PG8_WAIT_VE(); PG8_WAIT_L(0); PG8_BAR; PG8_MMA(1, 0, At, B0); PG8_MMA(1, 1, At, B1); PG8_BAR; PG8_SCHED;
            PG8_LDB(B0, 1, 0); PG8_LDB(B1, 1, 1); PG8_SCHED; PG8_LDA(At, 1, 0); PG8_STAGE(PG8_SA(0, 1), a2 + hstep, voffA);
            PG8_WAIT_VE(); PG8_WAIT_L(0); PG8_BAR; PG8_MMA(0, 0, At, B0); PG8_MMA(0, 1, At, B1); PG8_BAR; PG8_SCHED;
            PG8_LDA(At, 1, 1); PG8_STAGE(PG8_SB(1, 0), b3, voffB); PG8_STAGE(PG8_SB(1, 1), b3 + hstep, voffB); PG8_STAGE(PG8_SA(1, 0), a3, voffA);
            PG8_WAIT_V(8); PG8_WAIT_L(0); PG8_BAR; PG8_MMA(1, 0, At, B0); PG8_MMA(1, 1, At, B1); PG8_BAR; PG8_SCHED;
            t = 2;
        } }
        PG8_SCHED;
        for (; t < nt; t += 2) {
            if constexpr (PROF) { if (t == 4) pf_ks = __builtin_readcyclecounter(); }
            const bool last = (t == nt - 2);
            const char* a1 = cA + (size_t)(t + 1) * kstep;
            const char* a2 = last ? nA : cA + (size_t)(t + 2) * kstep; const char* b2 = last ? nB : cB + (size_t)(t + 2) * kstep;
            const char* a3 = a2 + kstep; const char* b3 = b2 + kstep;
            if (last && has_next) S.a_ready(nxt);
            if constexpr (SP2) {
            PG8_LDB(B0, 0, 0); PG8_LDB(B1, 0, 1); PG8_SCHED; PG8_LDA(At, 0, 0); PG8_STAGE(PG8_SA(1, 1), a1 + hstep, voffA);
            PG8_WAIT_V(8); PG8_WAIT_L(0); PG8_BAR; PG8_MMA(0, 0, At, B0); PG8_MMA(0, 1, At, B1); PG8_BAR; PG8_SCHED;
            PG8_LDA(At, 0, 1); PG8_STAGE(PG8_SB(0, 0), b2, voffB); PG8_STAGE(PG8_SB(0, 1), b2 + hstep, voffB); PG8_STAGE(PG8_SA(0, 0), a2, voffA);
            PG8_WAIT_V(8); PG8_WAIT_L(0); PG8_BAR; PG8_MMA(1, 0, At, B0); PG8_MMA(1, 1, At, B1); PG8_BAR; PG8_SCHED;
            PG8_LDB(B0, 1, 0); PG8_LDB(B1, 1, 1); PG8_SCHED; PG8_LDA(At, 1, 0); PG8_STAGE(PG8_SA(0, 1), a2 + hstep, voffA);
            PG8_WAIT_V(8); PG8_WAIT_L(0); PG8_BAR; PG8_MMA(0, 0, At, B0); PG8_MMA(0, 1, At, B1); PG8_BAR; PG8_SCHED;
            PG8_LDA(At, 1, 1); PG8_STAGE(PG8_SB(1, 0), b3, voffB); PG8_STAGE(PG8_SB(1, 1), b3 + hstep, voffB); PG8_STAGE(PG8_SA(1, 0), a3, voffA);
            PG8_WAIT_V(8); PG8_WAIT_L(0); PG8_BAR; PG8_MMA(1, 0, At, B0); PG8_MMA(1, 1, At, B1); PG8_BAR; PG8_SCHED;
            } else {
            PG8_LDB(B0, 0, 0); PG8_SCHED; PG8_LDA(At, 0, 0); PG8_STAGE(PG8_SA(1, 1), a1 + hstep, voffA);
            PG8_WAIT_L(8); PG8_BAR; PG8_WAIT_L(0); PG8_MMA(0, 0, At, B0); PG8_BAR; PG8_SCHED;
            PG8_LDB(B1, 0, 1); PG8_STAGE(PG8_SB(0, 0), b2, voffB);
            PG8_BAR; PG8_WAIT_L(0); PG8_MMA(0, 1, At, B1); PG8_BAR;
            PG8_LDA(At, 0, 1); PG8_STAGE(PG8_SA(0, 0), a2, voffA);
            PG8_BAR; PG8_WAIT_L(0); PG8_MMA(1, 0, At, B0); PG8_BAR; PG8_SCHED;
            PG8_STAGE(PG8_SB(0, 1), b2 + hstep, voffB);
            PG8_WAIT_V(6); PG8_BAR; PG8_MMA(1, 1, At, B1); PG8_BAR;
            PG8_LDB(B0, 1, 0); PG8_SCHED; PG8_LDA(At, 1, 0); PG8_STAGE(PG8_SA(0, 1), a2 + hstep, voffA);
            PG8_WAIT_L(8); PG8_BAR; PG8_WAIT_L(0); PG8_MMA(0, 0, At, B0); PG8_BAR; PG8_SCHED;
            PG8_LDB(B1, 1, 1); PG8_STAGE(PG8_SB(1, 0), b3, voffB);
            PG8_BAR; PG8_WAIT_L(0); PG8_MMA(0, 1, At, B1); PG8_BAR;
            PG8_LDA(At, 1, 1); PG8_STAGE(PG8_SA(1, 0), a3, voffA);
            PG8_BAR; PG8_WAIT_L(0); PG8_MMA(1, 0, At, B0); PG8_BAR; PG8_SCHED;
            PG8_STAGE(PG8_SB(1, 1), b3 + hstep, voffB);
            PG8_WAIT_V(6); PG8_BAR; PG8_MMA(1, 1, At, B1); PG8_BAR;
            }
        }
        if constexpr (PROF) pf_kl += __builtin_readcyclecounter() - pf_ks;
        if constexpr (ALIGN_EPI) { if (wr == 0) PG8_BAR; }
        if constexpr (ALIGN_EPI && SP2 && Epi::PEEL) { if (has_next) PG8_STAGE(PG8_SA(1, 1), nA + kstep + hstep, voffA); }
        if constexpr (!Epi::AFTER_DRAIN) { E(acc, cur, wr, wc, fr, fq); S.done(cur); }
        if (!has_next) break;
#pragma unroll
        for (int a = 0; a < 2; ++a)
#pragma unroll
            for (int b = 0; b < 2; ++b)
#pragma unroll
                for (int m = 0; m < 4; ++m)
#pragma unroll
                    for (int n = 0; n < 2; ++n) acc[a][b][m][n] = (f32x4){0.f, 0.f, 0.f, 0.f};
        cur = nxt; cA = nA; cB = nB; ++ui;
        if constexpr (ALIGN_EPI) { if (wr == 1) PG8_BAR; }
    }
    PG8_WAIT_V(0);
    if constexpr (!ALIGN_EPI) { if (wr == 0) PG8_BAR; }
    PG8_BAR;
    if constexpr (Epi::AFTER_DRAIN) { E.fused(acc, cur, wr, wc, fr, fq, lds, wid, lane); S.done(cur); }
    if constexpr (PROF) { if (prof && blockIdx.x == 0 && tid == 0) { prof[0] = pf_kl; prof[1] = __builtin_readcyclecounter() - pf_t0; } }
#undef PG8_SA
#undef PG8_SB
#undef PG8_STAGE
#undef PG8_LDA
#undef PG8_LDB
#undef PG8_MMA
#undef PG8_WAIT_V
#undef PG8_WAIT_L
#undef PG8_BAR
#undef PG8_WAIT_VE
#undef PG8_SCHED
}
}

namespace att {
#define ATT_LAS __attribute__((address_space(3)))
typedef unsigned short bf16_t;
typedef short bf16x8 __attribute__((ext_vector_type(8)));
typedef short s16x4 __attribute__((ext_vector_type(4)));
typedef float f32x16 __attribute__((ext_vector_type(16)));
typedef float f32x4 __attribute__((ext_vector_type(4)));
typedef unsigned u32x4 __attribute__((ext_vector_type(4)));
typedef unsigned u32x2 __attribute__((ext_vector_type(2)));
constexpr int SEQ = 2048, PP = 3072, MIXP = 1024;
constexpr float LOG2E = 1.4426950408889634f;
#define ATT_MFMA(a, b, c) __builtin_amdgcn_mfma_f32_32x32x16_bf16((a), (b), (c), 0, 0, 0)
__device__ __forceinline__ constexpr int crow0(int i) { return (i & 3) + 8 * (i >> 2); }
__device__ __forceinline__ unsigned cvtpk(float lo, float hi) { typedef float f2 __attribute__((ext_vector_type(2))); typedef __bf16 b2 __attribute__((ext_vector_type(2)));
    f2 v = {lo, hi}; b2 b = __builtin_convertvector(v, b2); return __builtin_bit_cast(unsigned, b); }
__device__ __forceinline__ s16x4 vtr(const ATT_LAS unsigned char* p) { typedef short v4i16_t __attribute__((ext_vector_type(4)));
    return __builtin_bit_cast(s16x4, __builtin_amdgcn_ds_read_tr16_b64_v4i16((ATT_LAS v4i16_t*)p)); }
__device__ __forceinline__ float xhalf_max(float v) { auto rr = __builtin_amdgcn_permlane32_swap(__float_as_uint(v), __float_as_uint(v), false, false); return fmaxf(__uint_as_float(rr[0]), __uint_as_float(rr[1])); }
__device__ __forceinline__ float xhalf_sum(float v) { auto rr = __builtin_amdgcn_permlane32_swap(__float_as_uint(v), __float_as_uint(v), false, false); return __uint_as_float(rr[0]) + __uint_as_float(rr[1]); }
__device__ __forceinline__ float bf2f(unsigned short b) { return __uint_as_float((unsigned)b << 16); }

template <bool RET>
__device__ __forceinline__ void unit(ATT_LAS unsigned char* lds, const bf16_t* __restrict__ proj, bf16_t* __restrict__ mix, int b, int h, int qb,
                                     int layer, const float* __restrict__ lq1, const float* __restrict__ lk1, const float* __restrict__ lq2, const float* __restrict__ lk2, const float* __restrict__ subln) {
    constexpr int NMAP = RET ? 1 : 2;
    constexpr int KW = RET ? 64 : 128;
    constexpr int KP = KW * 2 + 16;
    constexpr int KIMG = 64 * KP, VIMG = 16384, BUF = KIMG + VIMG;
    constexpr int QOFF = 2 * BUF;
    constexpr int QCOL = RET ? 1536 : 0, KCOL = RET ? 1792 : 512, VCOL = RET ? 2048 : 1024;
    int tid_ = threadIdx.x; asm volatile("" : "+v"(tid_));
    const int tid = tid_, lane = tid & 63, r = lane & 31, hh = lane >> 5;
    const int wid = __builtin_amdgcn_readfirstlane(tid >> 6);
    const size_t rowbase = (size_t)b * SEQ;
    const int q0w = qb * 256 + wid * 32;
    const int NT = 4 * (qb + 1);
    const int my_last = (q0w + 31) >> 6;
    const float hc0 = RET ? __builtin_log2f(1.0f - __builtin_exp2f(-5.0f - (float)h)) : __builtin_exp2f(-2.0f * (float)(h + 1)) * LOG2E;

    bf16x8 qf[4];
    const int qpark = QOFF + wid * 8192 + lane * 16;
    { const bf16_t* qp = proj + (rowbase + q0w + r) * PP + QCOL + h * KW + 8 * hh;
#pragma unroll
      for (int c = 0; c < NMAP; ++c)
#pragma unroll
          for (int s = 0; s < 4; ++s) { const bf16x8 v = *(const bf16x8*)(qp + c * 64 + 16 * s);
              if constexpr (RET) qf[s] = v; else *(ATT_LAS bf16x8*)(lds + qpark + (c * 4 + s) * 1024) = v; } }

    const char* pbase = (const char*)(proj + rowbase * PP);
    const int vkey = tid >> 4, vc = tid & 15;
    const unsigned voff = (unsigned)(vkey * PP + h * 128 + vc * 8) * 2u;
    const int vdst = KIMG + (vc >> 2) * 4096 + vkey * 64 + (vc & 3) * 16;
    const int kkey = RET ? (tid >> 3) : (tid >> 4), kc = RET ? (tid & 7) : (tid & 15);
    const unsigned koff = (unsigned)(kkey * PP + h * KW + kc * 8) * 2u;
    const int kdst = kkey * KP + kc * 16;
    u32x4 kreg0, kreg1, vreg0, vreg1;
#define ATT_GLOAD(t) do { const char* tb_ = pbase + (size_t)(t) * (64 * PP * 2); \
        kreg0 = *(const u32x4*)(tb_ + KCOL * 2 + koff); if constexpr (!RET) kreg1 = *(const u32x4*)(tb_ + KCOL * 2 + 32 * PP * 2 + koff); \
        vreg0 = *(const u32x4*)(tb_ + VCOL * 2 + voff); vreg1 = *(const u32x4*)(tb_ + VCOL * 2 + 32 * PP * 2 + voff); } while (0)
#define ATT_LWRITE(bo) do { *(ATT_LAS u32x4*)(lds + (bo) + kdst) = kreg0; if constexpr (!RET) *(ATT_LAS u32x4*)(lds + (bo) + kdst + 32 * KP) = kreg1; \
        *(ATT_LAS u32x4*)(lds + (bo) + vdst) = vreg0; *(ATT_LAS u32x4*)(lds + (bo) + vdst + 2048) = vreg1; } while (0)

    f32x16 O[NMAP][4];
#pragma unroll
    for (int c = 0; c < NMAP; ++c)
#pragma unroll
        for (int k = 0; k < 4; ++k)
#pragma unroll
            for (int i = 0; i < 16; ++i) O[c][k][i] = 0.f;
    float mref[NMAP], lsum[NMAP];
#pragma unroll
    for (int c = 0; c < NMAP; ++c) { mref[c] = -1e30f; lsum[c] = 0.f; }

    f32x16 cb;
#pragma unroll
    for (int i = 0; i < 16; ++i) cb[i] = RET ? 0.f : hc0 * (float)crow0(i);
    const int krd = r * KP + 16 * hh;
    const int vrd = KIMG + ((lane >> 4) & 1) * 32 + (lane & 3) * 8 + (4 * hh + ((lane & 15) >> 2)) * 64;

    ATT_GLOAD(0); ATT_LWRITE(0);
    __syncthreads();
    for (int t = 0; t < NT; ++t) {
        const int bo = (t & 1) * BUF;
        if (t + 1 < NT) ATT_GLOAD(t + 1);
        if (t <= my_last) {
            const bool diag = (t == my_last);
            float hc = hc0; asm volatile("" : "+v"(hc));
#pragma unroll
            for (int kb = 0; kb < 2; ++kb) {
                if (kb == 1 && diag && !(q0w & 32)) continue;
                const int ql = q0w + r - 64 * t - 4 * hh - 32 * kb;
                bf16x8 pf[NMAP][2];
#pragma unroll
                for (int c = 0; c < NMAP; ++c) {
                    if constexpr (!RET) {
#pragma unroll
                        for (int s = 0; s < 4; ++s) qf[s] = *(const ATT_LAS bf16x8*)(lds + qpark + (c * 4 + s) * 1024);
                    }
                    f32x16 sa;
                    if constexpr (RET) {
#pragma unroll
                        for (int i = 0; i < 16; ++i) sa[i] = 0.f;
                    } else sa = cb;
#pragma unroll
                    for (int s = 0; s < 4; ++s) { const bf16x8 kf = *(const ATT_LAS bf16x8*)(lds + bo + krd + kb * 32 * KP + c * 128 + s * 32);
                        sa = ATT_MFMA(kf, qf[s], sa); }
                    if constexpr (!RET) {
                        const float lanec = -hc * (float)ql;
                        if (diag) {
#pragma unroll
                            for (int i = 0; i < 16; ++i) if (crow0(i) > ql) sa[i] = -1e30f;
                        }
                        float tmax = sa[0];
#pragma unroll
                        for (int i = 1; i < 16; ++i) tmax = fmaxf(tmax, sa[i]);
                        float tm = xhalf_max(tmax + lanec);
                        if (__any(tm > mref[c] + 8.0f)) {
                            const float mnew = fmaxf(mref[c], tm), alpha = __builtin_amdgcn_exp2f(mref[c] - mnew);
                            lsum[c] *= alpha; mref[c] = mnew;
#pragma unroll
                            for (int k = 0; k < 4; ++k)
#pragma unroll
                                for (int i = 0; i < 16; ++i) O[c][k][i] *= alpha;
                        }
                        const float e = mref[c] - lanec; float ls = 0.f;
#pragma unroll
                        for (int i = 0; i < 16; ++i) { const float p = __builtin_amdgcn_exp2f(sa[i] - e); sa[i] = p; ls += p; }
                        lsum[c] += ls;
                    } else {
                        const float rf = __builtin_amdgcn_exp2f(hc * (float)(q0w + r - 64 * t - 32 * kb));
#pragma unroll
                        for (int i = 0; i < 16; ++i) sa[i] = sa[i] * rf;
                        if (diag) {
#pragma unroll
                            for (int i = 0; i < 16; ++i) if (crow0(i) > ql) sa[i] = 0.f;
                        }
                    }
#pragma unroll
                    for (int s = 0; s < 2; ++s) { u32x4 w;
                        w.x = cvtpk(sa[8 * s + 0], sa[8 * s + 1]); w.y = cvtpk(sa[8 * s + 2], sa[8 * s + 3]);
                        w.z = cvtpk(sa[8 * s + 4], sa[8 * s + 5]); w.w = cvtpk(sa[8 * s + 6], sa[8 * s + 7]);
                        pf[c][s] = __builtin_bit_cast(bf16x8, w); }
                }
#pragma unroll
                for (int k = 0; k < 4; ++k)
#pragma unroll
                    for (int s = 0; s < 2; ++s) {
                        const s16x4 lo = vtr(lds + bo + vrd + k * 4096 + (2 * kb + s) * 1024), hi = vtr(lds + bo + vrd + k * 4096 + (2 * kb + s) * 1024 + 512);
                        const bf16x8 vf = __builtin_shufflevector(lo, hi, 0, 1, 2, 3, 4, 5, 6, 7);
#pragma unroll
                        for (int c = 0; c < NMAP; ++c) O[c][k] = ATT_MFMA(vf, pf[c][s], O[c][k]);
                    }
            }
        }
        if (t + 1 < NT) ATT_LWRITE(((t + 1) & 1) * BUF);
        __syncthreads();
    }
#undef ATT_GLOAD
#undef ATT_LWRITE
    const size_t orow = rowbase + q0w + r;
#define ATT_SWAP(a_, b_) __builtin_amdgcn_permlane32_swap((a_), (b_), false, false)
    if constexpr (!RET) {
        int ly = layer; asm volatile("" : "+s"(ly));
        const float lam_init = 0.8f - 0.6f * __expf(-0.3f * (float)ly), omli = 1.0f - lam_init;
        float d1 = lq1[ly * 64 + lane] * lk1[ly * 64 + lane], d2 = lq2[ly * 64 + lane] * lk2[ly * 64 + lane];
#define ATT_SWZ(o) do { d1 += __int_as_float(__builtin_amdgcn_ds_swizzle(__float_as_int(d1), ((o) << 10) | 0x1f)); d2 += __int_as_float(__builtin_amdgcn_ds_swizzle(__float_as_int(d2), ((o) << 10) | 0x1f)); } while (0)
        ATT_SWZ(1); ATT_SWZ(2); ATT_SWZ(4); ATT_SWZ(8);
#undef ATT_SWZ
        { auto r1 = __builtin_amdgcn_permlane16_swap(__float_as_uint(d1), __float_as_uint(d1), false, false); d1 = __uint_as_float(r1[0]) + __uint_as_float(r1[1]);
          auto r2 = __builtin_amdgcn_permlane16_swap(__float_as_uint(d2), __float_as_uint(d2), false, false); d2 = __uint_as_float(r2[0]) + __uint_as_float(r2[1]); }
        d1 = xhalf_sum(d1); d2 = xhalf_sum(d2);
        const float lam = expf(d1) - expf(d2) + lam_init;
        float l1 = lsum[0], l2 = lsum[1];
        l1 = xhalf_sum(l1); l2 = xhalf_sum(l2);
        const float i1 = 1.0f / l1, i2 = lam / l2;
        float ss = 0.f;
#pragma unroll
        for (int k = 0; k < 4; ++k)
#pragma unroll
            for (int i = 0; i < 16; ++i) { const float o = O[0][k][i] * i1 - O[1][k][i] * i2; O[0][k][i] = o; ss += o * o; }
        ss = xhalf_sum(ss);
        const float rn = rsqrtf(ss * (1.0f / 128.0f) + 1e-6f) * omli;
        bf16_t* op = mix + orow * MIXP + h * 128 + 8 * hh;
#pragma unroll
        for (int k = 0; k < 4; ++k)
#pragma unroll
            for (int gp = 0; gp < 4; gp += 2) {
                u32x2 wg[2];
#pragma unroll
                for (int e = 0; e < 2; ++e) { const int g = gp + e;
                    const f32x4 gv = *(const f32x4*)(subln + 32 * k + 8 * g + 4 * hh);
                    wg[e].x = cvtpk(O[0][k][4 * g + 0] * rn * gv[0], O[0][k][4 * g + 1] * rn * gv[1]); wg[e].y = cvtpk(O[0][k][4 * g + 2] * rn * gv[2], O[0][k][4 * g + 3] * rn * gv[3]); }
                const auto s1 = ATT_SWAP(wg[0].x, wg[1].x), s2 = ATT_SWAP(wg[0].y, wg[1].y);
                u32x4 o; o.x = s1[0]; o.y = s2[0]; o.z = s1[1]; o.w = s2[1];
                *(u32x4*)(op + 32 * k + 8 * gp) = o;
            }
    } else {
        float ss = 0.f;
#pragma unroll
        for (int k = 0; k < 4; ++k)
#pragma unroll
            for (int i = 0; i < 16; ++i) ss += O[0][k][i] * O[0][k][i];
        ss = xhalf_sum(ss);
        const float rn = rsqrtf(ss * (1.0f / 128.0f) + 1e-6f);
        const bf16_t* gp_ = proj + orow * PP + 2560 + h * 128 + 8 * hh;
        bf16_t* op = mix + orow * MIXP + 512 + h * 128 + 8 * hh;
#pragma unroll
        for (int k = 0; k < 4; ++k)
#pragma unroll
            for (int gp = 0; gp < 4; gp += 2) {
                const u32x4 L = *(const u32x4*)(gp_ + 32 * k + 8 * gp);
                const auto t1 = ATT_SWAP(L.x, L.z), t2 = ATT_SWAP(L.y, L.w);
                u32x2 wg[2];
#pragma unroll
                for (int e = 0; e < 2; ++e) { const int g = gp + e; const unsigned gx = t1[e], gy = t2[e];
                    float gt[4] = {__uint_as_float(gx << 16), __uint_as_float(gx & 0xffff0000u), __uint_as_float(gy << 16), __uint_as_float(gy & 0xffff0000u)};
                    float ov[4];
#pragma unroll
                    for (int j = 0; j < 4; ++j) { const float sg = gt[j] * __builtin_amdgcn_rcpf(1.0f + __builtin_amdgcn_exp2f(-gt[j] * LOG2E)); ov[j] = O[0][k][4 * g + j] * rn * sg; }
                    wg[e].x = cvtpk(ov[0], ov[1]); wg[e].y = cvtpk(ov[2], ov[3]); }
                const auto s1 = ATT_SWAP(wg[0].x, wg[1].x), s2 = ATT_SWAP(wg[0].y, wg[1].y);
                u32x4 o; o.x = s1[0]; o.y = s2[0]; o.z = s1[1]; o.w = s2[1];
                *(u32x4*)(op + 32 * k + 8 * gp) = o;
            }
    }
#undef ATT_SWAP
}
}


#ifndef MK_MULTI_LAUNCH
#define MK_MULTI_LAUNCH 0
#endif
#define LAS __attribute__((address_space(3)))
typedef unsigned short bf16;
typedef float f32x4 __attribute__((ext_vector_type(4)));
typedef unsigned v4u __attribute__((ext_vector_type(4)));
typedef unsigned v2u __attribute__((ext_vector_type(2)));

#define XB_TMO      128
#define XB_XCNT(j)  (256  + 64 * (j))
#define XB_XSUB(j)  (1280 + 64 * (j))
#define XB_XGEN(j)  (2304 + 64 * (j))
#define XB_TOP      3328
#define XB_TOPGEN   3392
#define XCD_BAR_WORDS 3456
#define XB_SPIN_CAP (1u << 18)

__device__ __forceinline__ unsigned xb_ld(unsigned* p)              { return __hip_atomic_load(p, __ATOMIC_RELAXED, __HIP_MEMORY_SCOPE_AGENT); }
__device__ __forceinline__ unsigned xb_add(unsigned* p, unsigned v) { return __hip_atomic_fetch_add(p, v, __ATOMIC_RELAXED, __HIP_MEMORY_SCOPE_AGENT); }
__device__ __forceinline__ unsigned xb_xcc_id() { return (unsigned)__builtin_amdgcn_s_getreg((3 << 11) | 20) & 0xFu; }
#define XB_SPIN(cond, bar) do { unsigned _sp = 0; while (cond) { __builtin_amdgcn_s_sleep(1); \
    if ((++_sp & 255u) == 0u) { if (xb_ld(&(bar)[XB_TMO])) break; if (_sp > XB_SPIN_CAP) { atomicAdd(&(bar)[XB_TMO], 1u); break; } } } } while (0)

struct XcdBarrier {
    unsigned* bar; unsigned x;
    volatile LAS unsigned* st;
};

__device__ __forceinline__ XcdBarrier xcd_barrier_post(unsigned* bar, volatile LAS unsigned* st) {
    XcdBarrier b; b.bar = bar; b.x = xb_xcc_id(); b.st = st;
    if (threadIdx.x == 0) (void)xb_add(&bar[XB_XCNT(b.x)], 1u);
    return b;
}
__device__ __forceinline__ void xcd_barrier_complete(unsigned* bar, unsigned x, unsigned& nloc, unsigned& nx) {
    const unsigned G = gridDim.x * gridDim.y * gridDim.z;
    unsigned sum, cnt, mine, sp = 0u;
    for (;;) {
        sum = 0u; cnt = 0u; mine = 0u;
#pragma unroll
        for (unsigned j = 0; j < 16; ++j) { const unsigned c = xb_ld(&bar[XB_XCNT(j)]); sum += c; cnt += (c > 0u) ? 1u : 0u; mine = (j == x) ? c : mine; }
        if (sum == G) break;
        __builtin_amdgcn_s_sleep(1);
        if ((++sp & 255u) == 0u) { if (xb_ld(&bar[XB_TMO])) break; if (sp > XB_SPIN_CAP) { atomicAdd(&bar[XB_TMO], 1u); break; } }
    }
    nloc = mine > 0u ? mine : 1u; nx = cnt > 0u ? cnt : 1u;
}

__device__ __forceinline__ void xcd_barrier(const XcdBarrier& b, bool t0, bool local = false) {
    asm volatile("s_waitcnt vmcnt(0)" ::: "memory");
    __syncthreads();
    if (t0) {
        unsigned* bar = b.bar;
        __builtin_amdgcn_s_waitcnt(0);
        unsigned nloc = b.st[0], nx = b.st[1];
        if (nloc == 0u) { xcd_barrier_complete(bar, b.x, nloc, nx); b.st[0] = nloc; b.st[1] = nx; }
        const unsigned old = xb_add(&bar[XB_XSUB(b.x)], 1u);
        const unsigned gen = old / nloc;
        if (old + 1u == (gen + 1u) * nloc && local) {
            __builtin_amdgcn_fence(__ATOMIC_ACQUIRE, "agent");
            xb_add(&bar[XB_XGEN(b.x)], 1u);
            asm volatile("s_waitcnt vmcnt(0)" ::: "memory");
        } else if (old + 1u == (gen + 1u) * nloc) {
            __builtin_amdgcn_fence(__ATOMIC_RELEASE, "agent");
            asm volatile("s_waitcnt vmcnt(0)" ::: "memory");
            const unsigned og = xb_add(&bar[XB_TOP], 1u);
            const unsigned tg = og / nx;
            if (og + 1u == (tg + 1u) * nx) xb_add(&bar[XB_TOPGEN], 1u);
            else XB_SPIN(xb_ld(&bar[XB_TOPGEN]) == tg, bar);
            __builtin_amdgcn_fence(__ATOMIC_ACQUIRE, "agent");
            xb_add(&bar[XB_XGEN(b.x)], 1u);
            asm volatile("s_waitcnt vmcnt(0)" ::: "memory");
        } else {
            XB_SPIN(xb_ld(&bar[XB_XGEN(b.x)]) == gen, bar);
            __builtin_amdgcn_fence(__ATOMIC_ACQUIRE, "agent");
            asm volatile("s_waitcnt vmcnt(0)" ::: "memory");
        }
    }
    __syncthreads();
}

constexpr int BATCH = 16, SEQ = 2048, D = 1024, DEPTH = 2, FF = 2816, INC = 3072;
constexpr int M = BATCH * SEQ;
constexpr int NPH = 2 + 7 * DEPTH;
constexpr size_t MiB = 1u << 20;
constexpr size_t WS_RSS = 0;
constexpr size_t WS_WFF = 2 * MiB, WFF_SZ = (size_t)2 * FF * D * 2;
constexpr size_t WS_WDN = WS_WFF + 4 * WFF_SZ, WDN_SZ = (size_t)D * FF * 2;
constexpr size_t WS_WIN = WS_WDN + 4 * WDN_SZ, WIN_SZ = (size_t)INC * D * 2;
constexpr size_t WS_WOUT = WS_WIN + 2 * WIN_SZ, WOUT_SZ = (size_t)D * D * 2;
constexpr size_t WS_XB = WS_WOUT + 2 * WOUT_SZ;
constexpr size_t WS_MIX = WS_XB + (size_t)M * D * 2;
constexpr size_t WS_HP = WS_MIX + (size_t)M * D * 2;
constexpr size_t WS_END = WS_HP + (size_t)M * INC * 2;
constexpr size_t WS_CTL = WS_END, CTL_BYTES = 16384;
static_assert(WS_CTL + CTL_BYTES <= 512 * MiB && XCD_BAR_WORDS * 4 <= CTL_BYTES, "d_ws map");
constexpr int LDS_BYTES = 136 * 1024;

struct Args { const float* in[18]; float* out; unsigned char* ws; int ph_lo, ph_hi; };

__device__ __forceinline__ unsigned f2bf(float f) { unsigned u = __builtin_bit_cast(unsigned, f); return (u + 0x7fffu + ((u >> 16) & 1u)) >> 16; }
__device__ __forceinline__ unsigned pk2(float lo, float hi) { return f2bf(lo) | (f2bf(hi) << 16); }
__device__ __forceinline__ float wave_sum(float v) {
    v += __int_as_float(__builtin_amdgcn_ds_swizzle(__float_as_int(v), (1 << 10) | 0x1f));
    v += __int_as_float(__builtin_amdgcn_ds_swizzle(__float_as_int(v), (2 << 10) | 0x1f));
    v += __int_as_float(__builtin_amdgcn_ds_swizzle(__float_as_int(v), (4 << 10) | 0x1f));
    v += __int_as_float(__builtin_amdgcn_ds_swizzle(__float_as_int(v), (8 << 10) | 0x1f));
    return pg8::x32_sum(pg8::x16_sum(v));
}
__device__ __forceinline__ void tr_item(const float* __restrict__ W, int K, int N, bf16* __restrict__ WT, const float* __restrict__ gain, float cs, int k0, int n0, int drow0, LAS float* scr, int lane) {
    const int c4 = lane & 7, kr = lane >> 3;
    f32x4 v[8]; float g[8];
#pragma unroll
    for (int i = 0; i < 8; ++i) { const int kk = 8 * i + kr; v[i] = *(const f32x4*)(W + (size_t)(k0 + kk) * N + n0 + 4 * c4); g[i] = gain ? gain[k0 + kk] * cs : cs; }
#pragma unroll
    for (int i = 0; i < 8; ++i) { const int kk = 8 * i + kr; LAS float* d = scr + kk * 33 + 4 * c4;
        d[0] = v[i][0] * g[i]; d[1] = v[i][1] * g[i]; d[2] = v[i][2] * g[i]; d[3] = v[i][3] * g[i]; }
    asm volatile("s_waitcnt lgkmcnt(0)" ::: "memory");
    const int c = lane & 7;
#pragma unroll
    for (int j = 0; j < 4; ++j) { const int n = (lane >> 3) + 8 * j; const LAS float* s = scr + (8 * c) * 33 + n;
        v4u o; o.x = pk2(s[0 * 33], s[1 * 33]); o.y = pk2(s[2 * 33], s[3 * 33]); o.z = pk2(s[4 * 33], s[5 * 33]); o.w = pk2(s[6 * 33], s[7 * 33]);
        const int rho = ((n >> 2) & 1) * 16 + ((n >> 3) << 2) + (n & 3);
        *(v4u*)(WT + (size_t)(drow0 + rho) * K + k0 + 8 * c) = o; }
    asm volatile("s_waitcnt lgkmcnt(0)" ::: "memory");
}

__global__ void __launch_bounds__(512, 2) mega_fwd(Args args) {
    extern __shared__ __attribute__((aligned(16))) unsigned char lds_raw[];
    LAS unsigned char* lds = (LAS unsigned char*)lds_raw;
    cg::grid_group grid = cg::this_grid();
    const int G = gridDim.x, bx = blockIdx.x;
    const int vcu = (G % 8 == 0) ? (bx % 8) * (G / 8) + bx / 8 : bx;
    unsigned char* ws = args.ws;
    float* RSS = (float*)(ws + WS_RSS);
    bf16* XB = (bf16*)(ws + WS_XB); bf16* MIX = (bf16*)(ws + WS_MIX); bf16* HP = (bf16*)(ws + WS_HP);
    float* X = args.out;
    const int lo = args.ph_lo, hi = args.ph_hi;
    volatile LAS unsigned* bst = (volatile LAS unsigned*)(lds + LDS_BYTES - 64);
    if (threadIdx.x < 8) bst[threadIdx.x] = 0u;
    __syncthreads();
    XcdBarrier bar = xcd_barrier_post((unsigned*)(ws + WS_CTL), bst);
    if (threadIdx.x == 0) __hip_atomic_fetch_or((unsigned*)(ws + WS_CTL + 14336) + 16 * (blockIdx.x & 7), 1u << xb_xcc_id(), __ATOMIC_RELAXED, __HIP_MEMORY_SCOPE_AGENT);
#define IN(k) (lo <= (k) && (k) < hi)

#ifndef PROF_P
#define PROF_P -1
#endif
#ifndef PROBE_KINDS
#define PROBE_KINDS 0u
#endif
    constexpr int PMUL = PROBE_KINDS ? 2 : 1;
#pragma unroll 1
    for (int pp = lo * PMUL; pp < hi * PMUL; ++pp) {
    const int p = pp / PMUL;
    const int pk = (p == 0) ? 7 : (p == NPH - 1) ? 8 : (p - 1) % 7;
    const int l = (p - 1) / 7;
    if (PMUL > 1 && (pp % PMUL) && !((PROBE_KINDS >> pk) & 1u)) continue;
    int tid_ = threadIdx.x; asm volatile("" : "+v"(tid_));
    const int tid = tid_, lane = tid & 63, wave = __builtin_amdgcn_readfirstlane(tid >> 6); (void)tid;
    if (pk == 7) {
        LAS float* scr = (LAS float*)(lds + wave * 16384);
        const int gw = vcu * 8 + wave, NGW = G * 8;
        constexpr int PER_LAYER = 6 * 1408 + 1536 + 512, TOTAL = DEPTH * PER_LAYER;
        for (int g = gw; g < TOTAL; g += NGW) {
            const int ll = g / PER_LAYER; int r = g % PER_LAYER;
            if (r < 4 * 1408) {
                const int m = r / 1408, it = r % 1408, f = m >> 1, up = m & 1;
                const float* W = args.in[f == 0 ? (up ? 3 : 2) : (up ? 15 : 14)] + (size_t)ll * D * FF;
                const float* gain = args.in[f == 0 ? 1 : 13] + ll * D;
                bf16* WT = (bf16*)(ws + WS_WFF + (size_t)(ll * 2 + f) * WFF_SZ);
                const int kb = it / 88, nb = it % 88, n0 = nb * 32;
                tr_item(W, D, FF, WT, gain, 1.0f, kb * 64, n0, 256 * (n0 >> 7) + 128 * up + (n0 & 127), scr, lane);
            } else if (r < 6 * 1408) {
                const int m = r / 1408 - 4, it = r % 1408;
                const float* W = args.in[m == 0 ? 4 : 16] + (size_t)ll * FF * D;
                bf16* WT = (bf16*)(ws + WS_WDN + (size_t)(ll * 2 + m) * WDN_SZ);
                const int kb = it / 32, nb = it % 32;
                tr_item(W, FF, D, WT, nullptr, 1.0f, kb * 64, nb * 32, nb * 32, scr, lane);
            } else if (r < 6 * 1408 + 1536) {
                const int it = r - 6 * 1408, kb = it / 96, nb = it % 96, n0 = nb * 32;
                const float cs = (n0 < 512) ? 0.125f * 1.4426950408889634f : ((n0 >= 1792 && n0 < 2048) ? 0.125f : 1.0f);
                tr_item(args.in[6] + (size_t)ll * D * INC, D, INC, (bf16*)(ws + WS_WIN + (size_t)ll * WIN_SZ), args.in[5] + ll * D, cs, kb * 64, n0, n0, scr, lane);
            } else {
                const int it = r - 6 * 1408 - 1536, kb = it / 32, nb = it % 32;
                tr_item(args.in[12] + (size_t)ll * D * D, D, D, (bf16*)(ws + WS_WOUT + (size_t)ll * WOUT_SZ), nullptr, 1.0f, kb * 64, nb * 32, nb * 32, scr, lane);
            }
        }
        const float* x = args.in[0];
        for (int m = gw; m < M; m += 2 * NGW) {
            const int m2 = m + NGW;
            const f32x4* xr0 = (const f32x4*)(x + (size_t)m * D) + lane; const f32x4* xr1 = (const f32x4*)(x + (size_t)(m2 < M ? m2 : m) * D) + lane;
            f32x4 v0[4], v1[4];
#pragma unroll
            for (int j = 0; j < 4; ++j) { v0[j] = xr0[64 * j]; v1[j] = xr1[64 * j]; }
            float s0 = 0.f, s1 = 0.f;
            v2u* o0 = (v2u*)(XB + (size_t)m * D) + lane; v2u* o1 = (v2u*)(XB + (size_t)(m2 < M ? m2 : m) * D) + lane;
#pragma unroll
            for (int j = 0; j < 4; ++j) {
                s0 += (v0[j][0] * v0[j][0] + v0[j][1] * v0[j][1]) + (v0[j][2] * v0[j][2] + v0[j][3] * v0[j][3]);
                s1 += (v1[j][0] * v1[j][0] + v1[j][1] * v1[j][1]) + (v1[j][2] * v1[j][2] + v1[j][3] * v1[j][3]);
                v2u w; w.x = pk2(v0[j][0], v0[j][1]); w.y = pk2(v0[j][2], v0[j][3]); o0[64 * j] = w;
                if (m2 < M) { v2u w1; w1.x = pk2(v1[j][0], v1[j][1]); w1.y = pk2(v1[j][2], v1[j][3]); o1[64 * j] = w1; } }
            s0 = wave_sum(s0); s1 = wave_sum(s1);
            if (lane < 16) { RSS[(size_t)m * 16 + lane] = lane == 0 ? s0 : 0.f; if (m2 < M) RSS[(size_t)m2 * 16 + lane] = lane == 0 ? s1 : 0.f; }
        }
    } else if (pk == 0 || pk == 5) {
        const int f = pk == 5;
        pg8::Gemm g{XB, (const bf16*)(ws + WS_WFF + (size_t)(l * 2 + f) * WFF_SZ), M, 2 * FF, D}; pg8::StaticOrder S; S.init(M, 2 * FF, G, bx);
        pg8::EpiSwiglu E{HP, FF, RSS, {0.f, 0.f, 0.f, 0.f, 0.f, 0.f, 0.f, 0.f}, -1};
        if (PROF_P >= 0 && p == PROF_P) pg8::gemm_phase<pg8::EpiSwiglu, pg8::StaticOrder, true, true, true>(lds, g, S, E, (unsigned long long*)(ws + WS_CTL + 15360));
        else pg8::gemm_phase<pg8::EpiSwiglu, pg8::StaticOrder, true, true>(lds, g, S, E);
    } else if (pk == 2) {
        pg8::Gemm g{XB, (const bf16*)(ws + WS_WIN + (size_t)l * WIN_SZ), M, INC, D}; pg8::StaticOrder S; S.init(M, INC, G, bx);
        pg8::EpiProj E{HP, INC, RSS, {0.f, 0.f, 0.f, 0.f, 0.f, 0.f, 0.f, 0.f}, -1};
        pg8::gemm_phase<pg8::EpiProj, pg8::StaticOrder, true, true>(lds, g, S, E);
    } else if (pk == 3) {
        const float* subln = args.in[11] + l * 128;
        for (int v = vcu; v < 256; v += G) {
            const int bh = v >> 2, s = v & 3, b = bh >> 2, h = bh & 3;
#pragma unroll 1
            for (int i = 0; i < 2; ++i) att::unit<false>(lds, HP, MIX, b, h, i == 0 ? 7 - s : s, l, args.in[7], args.in[8], args.in[9], args.in[10], subln);
#pragma unroll 1
            for (int i = 0; i < 2; ++i) att::unit<true>(lds, HP, MIX, b, h, i == 0 ? 7 - s : s, 0, nullptr, nullptr, nullptr, nullptr, nullptr);
        }
    } else if (pk == 8) {
        const float* gf = args.in[17];
        const bool own = (G == 256);
        const int gw = own ? 4096 * (bx & 7) + (bx >> 3) * 8 + wave : vcu * 8 + wave, NGW = own ? 256 : G * 8, mend = own ? 4096 * (bx & 7) + 4096 : M;
        for (int m = gw; m < mend; m += NGW) {
            float s = lane < 16 ? RSS[(size_t)m * 16 + lane] : 0.f; s = wave_sum(s);
            const float rstd = rsqrtf(s * (1.0f / D) + 1e-6f);
            const v2u* xb = (const v2u*)(XB + (size_t)m * D) + lane;
            f32x4* xr = (f32x4*)(X + (size_t)m * D) + lane;
#pragma unroll
            for (int j = 0; j < 4; ++j) { const v2u w = xb[64 * j]; const f32x4 gv = ((const f32x4*)gf)[lane + 64 * j];
                f32x4 v; v[0] = __uint_as_float(w.x << 16); v[1] = __uint_as_float(w.x & 0xffff0000u); v[2] = __uint_as_float(w.y << 16); v[3] = __uint_as_float(w.y & 0xffff0000u);
                xr[64 * j] = v * rstd * gv; }
        }
        if (PROF_P >= 0) { __syncthreads(); if (bx == 0 && tid == 0) { const unsigned long long* pr = (const unsigned long long*)(ws + WS_CTL + 15360); asm volatile("s_waitcnt vmcnt(0)" ::: "memory"); X[0] = 100.0f * (float)pr[0] / (float)pr[1]; } }
    } else {
        const bool outp = pk == 4; const int f = pk == 6;
        const bf16* A = outp ? MIX : HP;
        const bf16* Bt = outp ? (const bf16*)(ws + WS_WOUT + (size_t)l * WOUT_SZ) : (const bf16*)(ws + WS_WDN + (size_t)(l * 2 + f) * WDN_SZ);
        pg8::Gemm g{A, Bt, M, D, outp ? D : FF}; pg8::StaticOrder S; S.init(M, D, G, bx);
        pg8::EpiResid E{XB, RSS, outp ? 1.0f : 0.5f};
        if (PROF_P >= 0 && p == PROF_P) pg8::gemm_phase<pg8::EpiResid, pg8::StaticOrder, true, true, true>(lds, g, S, E, (unsigned long long*)(ws + WS_CTL + 15360));
        else pg8::gemm_phase<pg8::EpiResid, pg8::StaticOrder, true, true>(lds, g, S, E);
    }
    if (pp + 1 < hi * PMUL) {
        unsigned lz = 0u; asm volatile("" : "+v"(lz));
        const bool t0 = (wave == 0) && (__builtin_amdgcn_mbcnt_hi(~0u, __builtin_amdgcn_mbcnt_lo(~0u, lz)) == 0u);
        if (lo < 0) grid.sync();
        else if (p == 0) {
            xcd_barrier(bar, t0);
            if (t0) {
                unsigned ok = (G == 256) ? 1u : 0u;
#pragma unroll
                for (int j = 0; j < 8; ++j) { const unsigned m_ = __hip_atomic_load((unsigned*)(ws + WS_CTL + 14336) + 16 * j, __ATOMIC_RELAXED, __HIP_MEMORY_SCOPE_AGENT); if (m_ == 0u || (m_ & (m_ - 1u)) != 0u) ok = 0u; }
                bst[2] = ok;
            }
            __syncthreads();
        } else xcd_barrier(bar, t0, bst[2] != 0u);
    }
    }
#undef IN
}

extern "C" void kernel_launch(void* const* d_in, const int* in_sizes, int n_in, void* d_out, int out_size, void* d_ws, size_t ws_size, hipStream_t stream) {
    static int grid = 0;
    if (grid == 0) {
        if (n_in != 18 || out_size != M * D || ws_size < WS_CTL + CTL_BYTES) { fprintf(stderr, "kernel_launch: unexpected shapes (n_in %d out %d ws %zu)\n", n_in, out_size, ws_size); grid = -1; return; }
        int dev = 0, cus = 0, per_cu = 0;
        (void)hipGetDevice(&dev); (void)hipDeviceGetAttribute(&cus, hipDeviceAttributeMultiprocessorCount, dev);
        if (hipFuncSetAttribute((const void*)mega_fwd, hipFuncAttributeMaxDynamicSharedMemorySize, LDS_BYTES) != hipSuccess) { fprintf(stderr, "kernel_launch: hipFuncSetAttribute failed\n"); grid = -1; return; }
        if (hipOccupancyMaxActiveBlocksPerMultiprocessor(&per_cu, (const void*)mega_fwd, 512, LDS_BYTES) != hipSuccess || per_cu < 1) { fprintf(stderr, "kernel_launch: occupancy query says %d\n", per_cu); per_cu = 1; }
        (void)hipGetLastError();
        grid = cus * 1;
        if (grid <= 0) grid = 256;
    }
    if (grid < 0) return;
    (void)hipMemsetAsync((unsigned char*)d_ws + WS_CTL, 0, CTL_BYTES, stream);
    Args a{};
    for (int i = 0; i < 18; ++i) a.in[i] = (const float*)d_in[i];
    a.out = (float*)d_out; a.ws = (unsigned char*)d_ws;
#if MK_MULTI_LAUNCH
    for (int p = 0; p < NPH; ++p) { a.ph_lo = p; a.ph_hi = p + 1; hipLaunchKernelGGL(mega_fwd, dim3(grid), dim3(512), LDS_BYTES, stream, a); }
#else
    a.ph_lo = 0; a.ph_hi = NPH;
    void* kargs[] = {&a};
    hipError_t e = hipLaunchCooperativeKernel((const void*)mega_fwd, dim3(grid), dim3(512), kargs, LDS_BYTES, stream);
    if (e != hipSuccess) fprintf(stderr, "cooperative launch failed: %s (grid %d)\n", hipGetErrorString(e), grid);
#endif
}
```
